# Optimizing an MI355X kernel written in HIP

```python
import math
import jax, jax.numpy as jnp
from jax import lax
import numpy as np

D_MODEL = 1024
BATCH = 2
SEQ = 8192
DEPTH = 1

CHUNK = 64
Q_BLOCK = 128
RMS_EPS = 1e-6
D_FF = 4 * D_MODEL

RW_HEADS = 8
RW_HEAD_DIM = 64
RW_WIDTH = RW_HEADS * RW_HEAD_DIM
RW_DECAY_LORA = 64
RW_ICLR_LORA = 64
RW_GATE_LORA = 128
RW_GN_EPS = 1e-5 * RW_HEAD_DIM
RW_IN = 3 * RW_WIDTH + RW_DECAY_LORA + RW_ICLR_LORA + RW_GATE_LORA

DA_HEADS = 4
DA_QK_DIM = 64
DA_V_DIM = 2 * DA_QK_DIM
DA_QK_WIDTH = DA_HEADS * 2 * DA_QK_DIM
DA_V_WIDTH = DA_HEADS * DA_V_DIM
DA_IN = 2 * DA_QK_WIDTH + DA_V_WIDTH
DA_SUBLN_EPS = 1e-5

GATE_IN = 2 * D_MODEL
IN_WIDTH = RW_IN + DA_IN + GATE_IN

kernel_name = "hybrid_rwkv7_diffattn_gated_block"


def rms_norm(x, g, eps=RMS_EPS):
    xf = x.astype(jnp.float32)
    y = xf * lax.rsqrt(jnp.mean(xf * xf, axis=-1, keepdims=True) + eps)
    return (y * g.astype(jnp.float32)).astype(x.dtype)


def token_shift(u):
    return jnp.pad(u, ((0, 0), (1, 0), (0, 0)))[:, :-1]


def wkv7_scan(r, decay, k, v, kk, a):
    b, s, h, d = r.shape
    seq_first = lambda t: jnp.transpose(t, (1, 0, 2, 3))

    def step(state, inp):
        r_t, w_t, k_t, v_t, kk_t, a_t = inp
        sa = jnp.einsum('bhij,bhj->bhi', state, -kk_t)
        state = (state * w_t[:, :, None, :]
                 + sa[..., None] * (kk_t * a_t)[:, :, None, :]
                 + v_t[..., None] * k_t[:, :, None, :])
        y = jnp.einsum('bhij,bhj->bhi', state, r_t)
        return state, y

    state0 = jnp.zeros((b, h, d, d), jnp.float32)
    _, ys = lax.scan(step, state0, tuple(seq_first(t) for t in (r, decay, k, v, kk, a)))
    return jnp.transpose(ys, (1, 0, 2, 3))


def rwkv7_time_mix(u, mu, w0, w2, a0, a2, g2, k_k, k_a, r_k, gn_g, gn_b):
    b, s, _ = u.shape
    u = u + (token_shift(u) - u) * mu
    o1 = RW_WIDTH; o2 = 2 * RW_WIDTH; o3 = 3 * RW_WIDTH
    o4 = o3 + RW_DECAY_LORA; o5 = o4 + RW_ICLR_LORA
    r, k, v = u[..., :o1], u[..., o1:o2], u[..., o2:o3]
    xw, xa, xg = u[..., o3:o4], u[..., o4:o5], u[..., o5:]
    f32 = jnp.float32
    w_log = -jax.nn.softplus(-(w0 + jnp.tanh(xw) @ w2).astype(f32)) - 0.5
    decay = jnp.exp(-jnp.exp(w_log))
    a = jax.nn.sigmoid((a0 + xa @ a2).astype(f32))
    g = jax.nn.sigmoid(xg) @ g2
    heads = lambda t: t.astype(f32).reshape(b, s, RW_HEADS, RW_HEAD_DIM)
    r_h, k_h, v_h, a_h, w_h = heads(r), heads(k), heads(v), heads(a), heads(decay)
    kk = k_h * heads(k_k[None, None, :] * jnp.ones((b, s, 1), f32))
    kk = kk / jnp.maximum(jnp.linalg.norm(kk, axis=-1, keepdims=True), 1e-12)
    k_h = k_h * (1.0 + (a_h - 1.0) * k_a.astype(f32).reshape(RW_HEADS, RW_HEAD_DIM))
    y = wkv7_scan(r_h, w_h, k_h, v_h, kk, a_h)
    mean = jnp.mean(y, axis=-1, keepdims=True)
    var = jnp.mean(jnp.square(y - mean), axis=-1, keepdims=True)
    y = ((y - mean) * lax.rsqrt(var + RW_GN_EPS)).reshape(b, s, RW_WIDTH)
    y = y * gn_g.astype(f32) + gn_b.astype(f32)
    bonus = jnp.sum(r_h * k_h * r_k.astype(f32), axis=-1, keepdims=True) * v_h
    out = (y + bonus.reshape(b, s, RW_WIDTH)) * g.astype(f32)
    return out.astype(u.dtype)


def diff_attention(u, lam_q1, lam_k1, lam_q2, lam_k2, sub_g, lambda_init):
    b, s, _ = u.shape
    q = u[..., :DA_QK_WIDTH].reshape(b, s, DA_HEADS, 2, DA_QK_DIM)
    k = u[..., DA_QK_WIDTH:2 * DA_QK_WIDTH].reshape(b, s, DA_HEADS, 2, DA_QK_DIM)
    v = u[..., 2 * DA_QK_WIDTH:].reshape(b, s, DA_HEADS, DA_V_DIM)
    f32 = jnp.float32
    lam = (jnp.exp(jnp.sum(lam_q1.astype(f32) * lam_k1.astype(f32)))
           - jnp.exp(jnp.sum(lam_q2.astype(f32) * lam_k2.astype(f32))) + lambda_init)
    scale = DA_QK_DIM ** -0.5
    n_blocks = s // Q_BLOCK
    q_blocks = jnp.transpose(q.reshape(b, n_blocks, Q_BLOCK, DA_HEADS, 2, DA_QK_DIM),
                             (1, 0, 2, 3, 4, 5))
    key_chunk = jnp.arange(s, dtype=jnp.int32) // CHUNK

    def block(args):
        qb, bi = args
        q_chunk = (bi * Q_BLOCK + jnp.arange(Q_BLOCK, dtype=jnp.int32)) // CHUNK
        mask = key_chunk[None, :] <= q_chunk[:, None]
        sc = jnp.einsum('bqhmd,bkhmd->bhmqk', qb, k).astype(f32) * scale
        sc = jnp.where(mask, sc, -jnp.inf)
        p = jax.nn.softmax(sc, axis=-1)
        attn = p[:, :, 0] - lam * p[:, :, 1]
        return jnp.einsum('bhqk,bkhd->bqhd', attn.astype(v.dtype), v)

    o = lax.map(block, (q_blocks, jnp.arange(n_blocks, dtype=jnp.int32)))
    o = jnp.transpose(o, (1, 0, 2, 3, 4)).reshape(b, s, DA_HEADS, DA_V_DIM)
    o = rms_norm(o, sub_g, DA_SUBLN_EPS) * (1.0 - lambda_init)
    return o.reshape(b, s, DA_V_WIDTH)


def setup_inputs(seed: int = 0) -> dict:
    key = jax.random.key(seed)
    ks = iter(jax.random.split(key, 40))
    nrm = lambda shape, scale: jax.random.normal(next(ks), shape, jnp.float32) * scale
    L = DEPTH
    gain = lambda n: 1.0 + nrm((L, n), 0.02)
    return {
        "x": nrm((BATCH, SEQ, D_MODEL), 1.0),
        "pre_mix_g": gain(D_MODEL),
        "w_in": nrm((L, D_MODEL, IN_WIDTH), D_MODEL ** -0.5),
        "rw_shift_mu": jax.random.uniform(next(ks), (L, RW_IN), jnp.float32),
        "rw_w0": 0.5 + nrm((L, RW_WIDTH), 0.5),
        "rw_w2": nrm((L, RW_DECAY_LORA, RW_WIDTH), 0.1),
        "rw_a0": nrm((L, RW_WIDTH), 0.5),
        "rw_a2": nrm((L, RW_ICLR_LORA, RW_WIDTH), 0.1),
        "rw_g2": nrm((L, RW_GATE_LORA, RW_WIDTH), RW_GATE_LORA ** -0.5),
        "rw_k_k": 0.85 + nrm((L, RW_WIDTH), 0.05),
        "rw_k_a": 1.0 + nrm((L, RW_WIDTH), 0.05),
        "rw_r_k": nrm((L, RW_HEADS, RW_HEAD_DIM), 0.1),
        "rw_gn_g": gain(RW_WIDTH),
        "rw_gn_b": nrm((L, RW_WIDTH), 0.02),
        "w_rw_out": nrm((L, RW_WIDTH, D_MODEL), RW_WIDTH ** -0.5),
        "da_lam_q1": nrm((L, DA_QK_DIM), 0.1),
        "da_lam_k1": nrm((L, DA_QK_DIM), 0.1),
        "da_lam_q2": nrm((L, DA_QK_DIM), 0.1),
        "da_lam_k2": nrm((L, DA_QK_DIM), 0.1),
        "da_sub_g": gain(DA_V_DIM),
        "w_da_out": nrm((L, DA_V_WIDTH, D_MODEL), DA_V_WIDTH ** -0.5),
        "w_o": nrm((L, D_MODEL, D_MODEL), D_MODEL ** -0.5),
        "post_mix_g": gain(D_MODEL),
        "pre_mlp_g": gain(D_MODEL),
        "w_up": nrm((L, D_MODEL, D_FF), D_MODEL ** -0.5),
        "w_down": nrm((L, D_FF, D_MODEL), D_FF ** -0.5),
        "post_mlp_g": gain(D_MODEL),
    }


def reference(x, pre_mix_g, w_in, rw_shift_mu, rw_w0, rw_w2, rw_a0, rw_a2, rw_g2, rw_k_k,
              rw_k_a, rw_r_k, rw_gn_g, rw_gn_b, w_rw_out, da_lam_q1, da_lam_k1, da_lam_q2,
              da_lam_k2, da_sub_g, w_da_out, w_o, post_mix_g, pre_mlp_g, w_up, w_down,
              post_mlp_g):
    for l in range(DEPTH):
        lambda_init = 0.8 - 0.6 * math.exp(-0.3 * l)
        h = rms_norm(x, pre_mix_g[l])
        z = h @ w_in[l]
        z_rw = z[..., :RW_IN]
        z_da = z[..., RW_IN:RW_IN + DA_IN]
        gate_rw = z[..., RW_IN + DA_IN:RW_IN + DA_IN + D_MODEL]
        gate_da = z[..., RW_IN + DA_IN + D_MODEL:]
        y_rw = rwkv7_time_mix(z_rw, rw_shift_mu[l], rw_w0[l], rw_w2[l], rw_a0[l], rw_a2[l],
                              rw_g2[l], rw_k_k[l], rw_k_a[l], rw_r_k[l], rw_gn_g[l],
                              rw_gn_b[l]) @ w_rw_out[l]
        y_da = diff_attention(z_da, da_lam_q1[l], da_lam_k1[l], da_lam_q2[l], da_lam_k2[l],
                              da_sub_g[l], lambda_init) @ w_da_out[l]
        merged = jax.nn.sigmoid(gate_rw) * y_rw + jax.nn.sigmoid(gate_da) * y_da
        x = x + rms_norm(merged @ w_o[l], post_mix_g[l])
        h = rms_norm(x, pre_mlp_g[l])
        f = jnp.square(jax.nn.relu(h @ w_up[l])) @ w_down[l]
        x = x + rms_norm(f, post_mlp_g[l])
    return x
```

```cpp
#include <hip/hip_runtime.h>
#include <hip/hip_cooperative_groups.h>
#include <cstdio>
#include <cstdint>
#include <cmath>
namespace cg = cooperative_groups;
namespace pg8 {
#define PG8_LAS __attribute__((address_space(3)))
typedef unsigned short bf16_t;
typedef short bf16x8 __attribute__((ext_vector_type(8)));
typedef float f32x4 __attribute__((ext_vector_type(4)));
typedef unsigned u32x4 __attribute__((ext_vector_type(4)));
constexpr int BM = 256, BK = 64, HALF = 128, HTB = HALF * BK * 2  , STAGE_BYTES = 8 * HTB, NXCD = 8, WGM = 8;

__host__ __device__ __forceinline__ int lds_byte(int r, int c) { const int st = (r >> 4) * 2 + (c >> 5), rr = r & 15, cc = c & 31, ob = rr * 64 + cc * 2; return st * 1024 + (ob ^ (((ob >> 9) & 1) << 5)); }
__host__ __device__ __forceinline__ void stage_rc(int b, int& R, int& C) { const int st = b / 1024, sb = b % 1024, swz = sb ^ (((sb >> 9) & 1) << 5); R = (st >> 1) * 16 + swz / 64; C = (st & 1) * 32 + (swz % 64) / 2; }
__host__ __device__ __forceinline__ int perm32(int rho) { const int n = rho >> 4, i = rho & 15; return 8 * (i >> 2) + 4 * n + (i & 3); }

struct Unit { int pm, pn; };
struct Gemm { const bf16_t* A; const bf16_t* Bt; int M, N, K; };

struct StaticOrder {
    int nM, nN, nwg, G, c;
    __host__ __device__ void init(int M, int N, int G_, int c_) { nM = M / BM; nN = N / BM; nwg = nM * nN; G = G_; c = c_; }
    __host__ __device__ bool next(int i, Unit& u) const {
        const long L = (long)i * G + c; if (L >= nwg) return false;
        int wgid = (int)L; { const int q = nwg / NXCD, r = nwg % NXCD, xcd = wgid % NXCD, off = wgid / NXCD; wgid = (xcd < r ? xcd * (q + 1) : r * (q + 1) + (xcd - r) * q) + off; }
        const int nig = WGM * nN, gid = wgid / nig, fm = gid * WGM, gsz = (nM - fm) < WGM ? (nM - fm) : WGM;
        u.pm = fm + ((wgid % nig) % gsz); u.pn = (wgid % nig) / gsz; return true;
    }
    __device__ __forceinline__ void a_ready(const Unit&) const {}
    __device__ __forceinline__ void done(const Unit&) const {}
};

__device__ __forceinline__ unsigned cvt_pk_bf16(float lo, float hi) { unsigned r; asm volatile("v_cvt_pk_bf16_f32 %0, %1, %2" : "=v"(r) : "v"(lo), "v"(hi)); return r; }
typedef float f32x2 __attribute__((ext_vector_type(2)));
__device__ __forceinline__ f32x2 gelu_pk(f32x2 v) {
    const f32x2 av = __builtin_elementwise_abs(v), d = av * 0.2316418882f + 1.0f;
    f32x2 t; t.x = __builtin_amdgcn_rcpf(d.x); t.y = __builtin_amdgcn_rcpf(d.y);
    f32x2 q = t * 0.5307027145f + (-0.7265760135f); q = q * t + 0.7107068705f; q = q * t + (-0.142248368f); q = q * t + 0.127414796f; q = q * t;
    const f32x2 s = (v * v) * (-0.72134752044f);
    f32x2 e; e.x = __builtin_amdgcn_exp2f(s.x); e.y = __builtin_amdgcn_exp2f(s.y);
    const f32x2 m = v * (q * e), r = v - m;
    f32x2 o; o.x = v.x < 0.f ? m.x : r.x; o.y = v.y < 0.f ? m.y : r.y; return o;
}

template <int ACT  > struct EpiBf16 {
    static constexpr bool PERM = true, AFTER_DRAIN = false; static_assert(ACT == 0 || ACT == 1, "EpiBf16: ACT is 0 (none) or 1 (gelu_pk)");
    bf16_t* O; int ldc; const float* bias; int split_cols; size_t split_stride; float scale0;
    __device__ __forceinline__ void operator()(const f32x4 (&acc)[2][2][4][2], const Unit& u, int wr, int wc, int fr, int fq) const {
        const int row0 = u.pm * BM + wr * 64 + fr; int colt = u.pn * BM; bf16_t* base = O;
        float sc = 1.f; if (split_cols) { const int t = colt / split_cols; base += (size_t)t * split_stride; colt -= t * split_cols; if (t == 0) sc = scale0; }
        const int col0 = colt + wc * 32 + 8 * fq, bcol0 = u.pn * BM + wc * 32 + 8 * fq;
        f32x4 bv[2][2];
#pragma unroll
        for (int bj = 0; bj < 2; ++bj)
#pragma unroll
            for (int n = 0; n < 2; ++n) bv[bj][n] = bias ? *(const f32x4*)(bias + bcol0 + bj * HALF + 4 * n) : (f32x4){0.f, 0.f, 0.f, 0.f};
#pragma unroll
        for (int ai = 0; ai < 2; ++ai)
#pragma unroll
            for (int m = 0; m < 4; ++m) { bf16_t* rowp = base + (size_t)(row0 + ai * HALF + m * 16) * ldc + col0;
#pragma unroll
                for (int bj = 0; bj < 2; ++bj) { f32x4 v0 = acc[ai][bj][m][0] + bv[bj][0], v1 = acc[ai][bj][m][1] + bv[bj][1];
                    if (ACT == 1) { f32x2 a = gelu_pk((f32x2){v0[0], v0[1]}), b = gelu_pk((f32x2){v0[2], v0[3]}), c = gelu_pk((f32x2){v1[0], v1[1]}), d = gelu_pk((f32x2){v1[2], v1[3]});
                        v0 = (f32x4){a.x, a.y, b.x, b.y}; v1 = (f32x4){c.x, c.y, d.x, d.y}; }
                    v0 = v0 * sc; v1 = v1 * sc; u32x4 w; w.x = cvt_pk_bf16(v0[0], v0[1]); w.y = cvt_pk_bf16(v0[2], v0[3]); w.z = cvt_pk_bf16(v1[0], v1[1]); w.w = cvt_pk_bf16(v1[2], v1[3]);
                    *(u32x4*)(rowp + bj * HALF) = w; } }
    }
};

template <class Epi, class Sched, bool ALIGN_EPI = false, bool SP2 = false>
__device__ __forceinline__ void gemm_phase(PG8_LAS unsigned char* lds, const Gemm g, const Sched& S, const Epi& E) {
    int tid_ = threadIdx.x; asm volatile("" : "+v"(tid_));
    const int tid = tid_, wid = __builtin_amdgcn_readfirstlane(tid >> 6), lane = tid & 63, wr = wid >> 2, wc = wid & 3, fr = lane & 15, fq = lane >> 4;
    const int K = g.K, nt = K / BK;
    unsigned voffA[2], voffB[2];
#pragma unroll
    for (int i = 0; i < 2; ++i) { int R, C; stage_rc(tid * 16 + i * 8192, R, C); const int Rb = Epi::PERM ? ((R & ~31) + perm32(R & 31)) : R;
        voffA[i] = (unsigned)(R * K + C) * 2u; voffB[i] = (unsigned)(Rb * K + C) * 2u; }
    const size_t kstep = (size_t)(BK * 2);
    const size_t hstep = (size_t)HALF * K * 2;
    const size_t tstep = 2 * hstep;
    const unsigned ldsw = (unsigned)wid * 1024u;
    const int aoff = lds_byte(wr * 64 + fr, fq * 8), boff = lds_byte(wc * 32 + fr, fq * 8);
#define PG8_SA(b, h) (((b) * 2 + (h)) * HTB)
#define PG8_SB(b, h) ((4 + (b) * 2 + (h)) * HTB)
#define PG8_STAGE(bufoff, gbase, voff) do { _Pragma("unroll") for (int _i = 0; _i < 2; ++_i) \
        __builtin_amdgcn_global_load_lds((const unsigned*)((const char*)(gbase) + (voff)[_i]), (PG8_LAS unsigned*)(lds + (bufoff) + ldsw + _i * 8192), 16, 0, 0); } while (0)
#define PG8_LDA(dst, b, h) do { _Pragma("unroll") for (int m = 0; m < 4; ++m) _Pragma("unroll") for (int k = 0; k < 2; ++k) dst[m][k] = *(const PG8_LAS bf16x8*)(lds + PG8_SA(b, h) + aoff + m * 2048 + k * 1024); } while (0)
#define PG8_LDB(dst, b, h) do { _Pragma("unroll") for (int n = 0; n < 2; ++n) _Pragma("unroll") for (int k = 0; k < 2; ++k) dst[n][k] = *(const PG8_LAS bf16x8*)(lds + PG8_SB(b, h) + boff + n * 2048 + k * 1024); } while (0)
#define PG8_MMA(ai, bj, At, Bt) do { __builtin_amdgcn_s_setprio(1); _Pragma("unroll") for (int m = 0; m < 4; ++m) _Pragma("unroll") for (int n = 0; n < 2; ++n) _Pragma("unroll") for (int k = 0; k < 2; ++k) \
        acc[ai][bj][m][n] = __builtin_amdgcn_mfma_f32_16x16x32_bf16(Bt[n][k], At[m][k], acc[ai][bj][m][n], 0, 0, 0); __builtin_amdgcn_s_setprio(0); } while (0)
#define PG8_WAIT_V(n) asm volatile("s_waitcnt vmcnt(" #n ")" ::: "memory")
#define PG8_WAIT_L(n) asm volatile("s_waitcnt lgkmcnt(" #n ")" ::: "memory")
#define PG8_BAR __builtin_amdgcn_s_barrier()
#define PG8_SCHED __builtin_amdgcn_sched_barrier(0)
    Unit cur, nxt; int ui = 0;
    if (!S.next(0, cur)) return;
    f32x4 acc[2][2][4][2];
#pragma unroll
    for (int a = 0; a < 2; ++a)
#pragma unroll
        for (int b = 0; b < 2; ++b)
#pragma unroll
            for (int m = 0; m < 4; ++m)
#pragma unroll
                for (int n = 0; n < 2; ++n) acc[a][b][m][n] = (f32x4){0.f, 0.f, 0.f, 0.f};
    bf16x8 At[4][2], B0[2][2], B1[2][2];
    const char* cA = (const char*)g.A + (size_t)cur.pm * tstep; const char* cB = (const char*)g.Bt + (size_t)cur.pn * tstep;
    S.a_ready(cur);
    if constexpr (SP2) {
        PG8_STAGE(PG8_SB(0, 0), cB, voffB); PG8_STAGE(PG8_SB(0, 1), cB + hstep, voffB); PG8_STAGE(PG8_SA(0, 0), cA, voffA); PG8_STAGE(PG8_SA(0, 1), cA + hstep, voffA);
        if (wr == 1) PG8_BAR;
        PG8_WAIT_V(2); PG8_BAR;
        PG8_STAGE(PG8_SB(1, 0), cB + kstep, voffB); PG8_STAGE(PG8_SA(1, 0), cA + kstep, voffA); PG8_STAGE(PG8_SB(1, 1), cB + hstep + kstep, voffB);
        PG8_WAIT_V(6); PG8_BAR;
    } else {
        PG8_STAGE(PG8_SB(0, 0), cB, voffB); PG8_STAGE(PG8_SA(0, 0), cA, voffA); PG8_STAGE(PG8_SB(0, 1), cB + hstep, voffB); PG8_STAGE(PG8_SA(0, 1), cA + hstep, voffA);
        if (wr == 1) PG8_BAR;
        PG8_WAIT_V(4); PG8_BAR;
        PG8_STAGE(PG8_SB(1, 0), cB + kstep, voffB); PG8_STAGE(PG8_SA(1, 0), cA + kstep, voffA); PG8_STAGE(PG8_SB(1, 1), cB + hstep + kstep, voffB);
        PG8_WAIT_V(6); PG8_BAR;
    }
    for (;;) {
        const bool has_next = S.next(ui + 1, nxt);
        const char* nA = has_next ? (const char*)g.A + (size_t)nxt.pm * tstep : cA; const char* nB = has_next ? (const char*)g.Bt + (size_t)nxt.pn * tstep : cB;
        for (int t = 0; t < nt; t += 2) {
            const bool last = (t == nt - 2);
            const char* a1 = cA + (size_t)(t + 1) * kstep;
            const char* a2 = last ? nA : cA + (size_t)(t + 2) * kstep; const char* b2 = last ? nB : cB + (size_t)(t + 2) * kstep;
            const char* a3 = a2 + kstep; const char* b3 = b2 + kstep;
            if (last && has_next) S.a_ready(nxt);
            if constexpr (SP2) {
            PG8_LDB(B0, 0, 0); PG8_LDB(B1, 0, 1); PG8_SCHED; PG8_LDA(At, 0, 0); PG8_STAGE(PG8_SA(1, 1), a1 + hstep, voffA);
            PG8_WAIT_V(8); PG8_WAIT_L(0); PG8_BAR; PG8_MMA(0, 0, At, B0); PG8_MMA(0, 1, At, B1); PG8_BAR; PG8_SCHED;
            PG8_LDA(At, 0, 1); PG8_STAGE(PG8_SB(0, 0), b2, voffB); PG8_STAGE(PG8_SB(0, 1), b2 + hstep, voffB); PG8_STAGE(PG8_SA(0, 0), a2, voffA);
            PG8_WAIT_V(8); PG8_WAIT_L(0); PG8_BAR; PG8_MMA(1, 0, At, B0); PG8_MMA(1, 1, At, B1); PG8_BAR; PG8_SCHED;
            PG8_LDB(B0, 1, 0); PG8_LDB(B1, 1, 1); PG8_SCHED; PG8_LDA(At, 1, 0); PG8_STAGE(PG8_SA(0, 1), a2 + hstep, voffA);
            PG8_WAIT_V(8); PG8_WAIT_L(0); PG8_BAR; PG8_MMA(0, 0, At, B0); PG8_MMA(0, 1, At, B1); PG8_BAR; PG8_SCHED;
            PG8_LDA(At, 1, 1); PG8_STAGE(PG8_SB(1, 0), b3, voffB); PG8_STAGE(PG8_SB(1, 1), b3 + hstep, voffB); PG8_STAGE(PG8_SA(1, 0), a3, voffA);
            PG8_WAIT_V(8); PG8_WAIT_L(0); PG8_BAR; PG8_MMA(1, 0, At, B0); PG8_MMA(1, 1, At, B1); PG8_BAR; PG8_SCHED;
            } else {
            PG8_LDB(B0, 0, 0); PG8_SCHED; PG8_LDA(At, 0, 0); PG8_STAGE(PG8_SA(1, 1), a1 + hstep, voffA);
            PG8_WAIT_L(8); PG8_BAR; PG8_WAIT_L(0); PG8_MMA(0, 0, At, B0); PG8_BAR; PG8_SCHED;
            PG8_LDB(B1, 0, 1); PG8_STAGE(PG8_SB(0, 0), b2, voffB);
            PG8_BAR; PG8_WAIT_L(0); PG8_MMA(0, 1, At, B1); PG8_BAR;
            PG8_LDA(At, 0, 1); PG8_STAGE(PG8_SA(0, 0), a2, voffA);
            PG8_BAR; PG8_WAIT_L(0); PG8_MMA(1, 0, At, B0); PG8_BAR; PG8_SCHED;
            PG8_STAGE(PG8_SB(0, 1), b2 + hstep, voffB);
            PG8_WAIT_V(6); PG8_BAR; PG8_MMA(1, 1, At, B1); PG8_BAR;
            PG8_LDB(B0, 1, 0); PG8_SCHED; PG8_LDA(At, 1, 0); PG8_STAGE(PG8_SA(0, 1), a2 + hstep, voffA);
            PG8_WAIT_L(8); PG8_BAR; PG8_WAIT_L(0); PG8_MMA(0, 0, At, B0); PG8_BAR; PG8_SCHED;
            PG8_LDB(B1, 1, 1); PG8_STAGE(PG8_SB(1, 0), b3, voffB);
            PG8_BAR; PG8_WAIT_L(0); PG8_MMA(0, 1, At, B1); PG8_BAR;
            PG8_LDA(At, 1, 1); PG8_STAGE(PG8_SA(1, 0), a3, voffA);
            PG8_BAR; PG8_WAIT_L(0); PG8_MMA(1, 0, At, B0); PG8_BAR; PG8_SCHED;
            PG8_STAGE(PG8_SB(1, 1), b3 + hstep, voffB);
            PG8_WAIT_V(6); PG8_BAR; PG8_MMA(1, 1, At, B1); PG8_BAR;
            }
        }
        if constexpr (ALIGN_EPI) { if (wr == 0) PG8_BAR; }
        if constexpr (!Epi::AFTER_DRAIN) { E(acc, cur, wr, wc, fr, fq); S.done(cur); }
        if (!has_next) break;
#pragma unroll
        for (int a = 0; a < 2; ++a)
#pragma unroll
            for (int b = 0; b < 2; ++b)
#pragma unroll
                for (int m = 0; m < 4; ++m)
#pragma unroll
                    for (int n = 0; n < 2; ++n) acc[a][b][m][n] = (f32x4){0.f, 0.f, 0.f, 0.f};
        cur = nxt; cA = nA; cB = nB; ++ui;
        if constexpr (ALIGN_EPI) { if (wr == 1) PG8_BAR; }
    }
    PG8_WAIT_V(0);
    if constexpr (!ALIGN_EPI) { if (wr == 0) PG8_BAR; }
    PG8_BAR;
    if constexpr (Epi::AFTER_DRAIN) { E.fused(acc, cur, wr, wc, fr, fq, lds, wid, lane); S.done(cur); }
#undef PG8_SA
#undef PG8_SB
#undef PG8_STAGE
#undef PG8_LDA
#undef PG8_LDB
#undef PG8_MMA
#undef PG8_WAIT_V
#undef PG8_WAIT_L
#undef PG8_BAR
#undef PG8_SCHED
}
}

constexpr int BATCH = 2, SEQ = 8192, DM = 1024, M = BATCH * SEQ, FF = 4096;
constexpr int RW_IN = 1792, DA_IN = 1536, GATE_IN = 2048, IN_W = 5376;
constexpr float C2 = 0.125f * 1.4426950408889634f;
constexpr float LAMBDA_INIT = 0.2f;
constexpr size_t KiB = 1024, MiB = 1u << 20;
constexpr size_t WS_CTL = 0;
constexpr size_t WS_WIN = 256 * KiB;
constexpr size_t WS_WRW = WS_WIN + (size_t)IN_W * DM * 2;
constexpr size_t WS_WDA = WS_WRW + 1 * MiB;
constexpr size_t WS_WO = WS_WDA + 1 * MiB;
constexpr size_t WS_WUP = WS_WO + 2 * MiB;
constexpr size_t WS_WDN = WS_WUP + 8 * MiB;
constexpr size_t WS_LORA = WS_WDN + 8 * MiB;
constexpr size_t WS_XN = WS_LORA + 768 * KiB;
constexpr size_t WS_ZRW = WS_XN + 32 * MiB;
constexpr size_t WS_ZDA = WS_ZRW + 56 * MiB;
constexpr size_t WS_ZG = WS_ZDA + 48 * MiB;
constexpr size_t WS_DAO = WS_ZG + 64 * MiB;
constexpr size_t WS_MERGED = WS_ZRW;
constexpr size_t WS_Y = WS_MERGED + 32 * MiB;
constexpr size_t WS_H = WS_ZRW;
constexpr size_t WS_F = WS_H + 128 * MiB;
constexpr size_t WS_END = WS_F + 64 * MiB;
static_assert(WS_XN == 32256 * KiB, "map");
static_assert(WS_DAO + 16 * MiB <= 256 * MiB && WS_END <= 256 * MiB, "d_ws map");
constexpr size_t DO_DEC = 0, DO_A = 16 * MiB, DO_G = 32 * MiB, DO_YRAW = 48 * MiB, DO_RWO = 0;

#define LAS __attribute__((address_space(3)))
typedef unsigned short bf16;
typedef unsigned v4u __attribute__((ext_vector_type(4)));
typedef unsigned v2u __attribute__((ext_vector_type(2)));
typedef float f32x4 __attribute__((ext_vector_type(4)));
constexpr int NWAVES = 8, NTHR = 512;
constexpr int LDS_BYTES = 147456;

__device__ __forceinline__ float bf2f(unsigned b) { return __uint_as_float(b << 16); }
__device__ __forceinline__ float bflo(unsigned w) { return __uint_as_float(w << 16); }
__device__ __forceinline__ float bfhi(unsigned w) { return __uint_as_float(w & 0xffff0000u); }
__device__ __forceinline__ unsigned f2bf(float f) { unsigned u = __float_as_uint(f); return (u + 0x7fffu + ((u >> 16) & 1u)) >> 16; }
__device__ __forceinline__ unsigned pk2(float lo, float hi) { return f2bf(lo) | (f2bf(hi) << 16); }
__device__ __forceinline__ float sigmoidf_(float x) { return 1.0f / (1.0f + __expf(-x)); }
__device__ __forceinline__ float wave_sum(float v) {
#pragma unroll
    for (int o = 1; o < 64; o <<= 1) v += __shfl_xor(v, o);
    return v;
}
__device__ __forceinline__ float wave_max(float v) {
#pragma unroll
    for (int o = 1; o < 64; o <<= 1) v = fmaxf(v, __shfl_xor(v, o));
    return v;
}

struct Args { const float* in[27]; float* out; unsigned char* ws; int ph_lo, ph_hi; };

struct EpiG1 {
    static constexpr bool PERM = true, AFTER_DRAIN = false;
    bf16 *zrw, *zda, *zg;
    __device__ __forceinline__ void operator()(const f32x4 (&acc)[2][2][4][2], const pg8::Unit& u, int wr, int wc, int fr, int fq) const {
        bf16* base; int ldc, colt; float sc = 1.f; bool sg = false;
        if (u.pn < 7) { base = zrw; ldc = RW_IN; colt = u.pn * 256; }
        else if (u.pn < 13) { base = zda; ldc = DA_IN; colt = (u.pn - 7) * 256; if (u.pn < 9) sc = C2; }
        else { base = zg; ldc = GATE_IN; colt = (u.pn - 13) * 256; sg = true; }
#pragma unroll
        for (int ai = 0; ai < 2; ++ai)
#pragma unroll
            for (int m = 0; m < 4; ++m) { const int row = u.pm * 256 + ai * 128 + wr * 64 + m * 16 + fr;
#pragma unroll
                for (int bj = 0; bj < 2; ++bj) { const int col = colt + bj * 128 + wc * 32 + 8 * fq;
                    f32x4 v0 = acc[ai][bj][m][0], v1 = acc[ai][bj][m][1];
                    if (sg) {
#pragma unroll
                        for (int e = 0; e < 4; ++e) { v0[e] = sigmoidf_(v0[e]); v1[e] = sigmoidf_(v1[e]); } }
                    else { v0 = v0 * sc; v1 = v1 * sc; }
                    v4u w; w.x = pg8::cvt_pk_bf16(v0[0], v0[1]); w.y = pg8::cvt_pk_bf16(v0[2], v0[3]); w.z = pg8::cvt_pk_bf16(v1[0], v1[1]); w.w = pg8::cvt_pk_bf16(v1[2], v1[3]);
                    *(v4u*)(base + (size_t)row * ldc + col) = w; } }
    }
};
struct EpiLora {
    static constexpr bool PERM = true, AFTER_DRAIN = false;
    bf16 *dec, *av, *gv; const float *w0, *a0;
    __device__ __forceinline__ unsigned one(float v, float bias, int kind) const {
        if (kind == 0) { const float y = -(bias + v); const float sp = fmaxf(y, 0.f) + __logf(1.0f + __expf(-fabsf(y)));
            const float d = __expf(-__expf(-sp - 0.5f)); float q = rintf((d - 0.5f) * 131070.0f); q = fminf(fmaxf(q, 0.f), 65535.f); return (unsigned)q; }
        if (kind == 1) return f2bf(1.0f / (1.0f + __expf(-(bias + v))));
        return f2bf(v);
    }
    __device__ __forceinline__ void operator()(const f32x4 (&acc)[2][2][4][2], const pg8::Unit& u, int wr, int wc, int fr, int fq) const {
        const int kind = u.pn >> 1; bf16* base = dec + (size_t)kind * ((size_t)M * 512); const int colt = (u.pn & 1) * 256;
        const float* bias = kind == 0 ? w0 : a0;
#pragma unroll
        for (int bj = 0; bj < 2; ++bj) { const int col = colt + bj * 128 + wc * 32 + 8 * fq;
            f32x4 b0 = (f32x4){0.f, 0.f, 0.f, 0.f}, b1 = b0;
            if (kind < 2) { b0 = *(const f32x4*)(bias + col); b1 = *(const f32x4*)(bias + col + 4); }
#pragma unroll
            for (int ai = 0; ai < 2; ++ai)
#pragma unroll
                for (int m = 0; m < 4; ++m) { const int row = u.pm * 256 + ai * 128 + wr * 64 + m * 16 + fr;
                    const f32x4 v0 = acc[ai][bj][m][0], v1 = acc[ai][bj][m][1];
                    v4u w;
                    w.x = one(v0[0], b0[0], kind) | (one(v0[1], b0[1], kind) << 16); w.y = one(v0[2], b0[2], kind) | (one(v0[3], b0[3], kind) << 16);
                    w.z = one(v1[0], b1[0], kind) | (one(v1[1], b1[1], kind) << 16); w.w = one(v1[2], b1[2], kind) | (one(v1[3], b1[3], kind) << 16);
                    *(v4u*)(base + (size_t)row * 512 + col) = w; asm volatile("" ::: "memory"); } }
    }
};
template <int MODE> struct EpiGate {
    static constexpr bool PERM = true, AFTER_DRAIN = false;
    const bf16* sg; int goff; float* tmp; bf16* merged;
    __device__ __forceinline__ void operator()(const f32x4 (&acc)[2][2][4][2], const pg8::Unit& u, int wr, int wc, int fr, int fq) const {
#pragma unroll
        for (int ai = 0; ai < 2; ++ai)
#pragma unroll
            for (int m = 0; m < 4; ++m) { const int row = u.pm * 256 + ai * 128 + wr * 64 + m * 16 + fr;
#pragma unroll
                for (int bj = 0; bj < 2; ++bj) { const int col = u.pn * 256 + bj * 128 + wc * 32 + 8 * fq;
                    const v4u g = *(const v4u*)(sg + (size_t)row * GATE_IN + goff + col);
                    f32x4 v0 = acc[ai][bj][m][0], v1 = acc[ai][bj][m][1];
                    v0[0] *= bflo(g.x); v0[1] *= bfhi(g.x); v0[2] *= bflo(g.y); v0[3] *= bfhi(g.y);
                    v1[0] *= bflo(g.z); v1[1] *= bfhi(g.z); v1[2] *= bflo(g.w); v1[3] *= bfhi(g.w);
                    float* tp = tmp + (size_t)row * DM + col;
                    if (MODE == 0) { *(f32x4*)tp = v0; *(f32x4*)(tp + 4) = v1; }
                    else { v0 += *(const f32x4*)tp; v1 += *(const f32x4*)(tp + 4);
                        v4u w; w.x = pg8::cvt_pk_bf16(v0[0], v0[1]); w.y = pg8::cvt_pk_bf16(v0[2], v0[3]); w.z = pg8::cvt_pk_bf16(v1[0], v1[1]); w.w = pg8::cvt_pk_bf16(v1[2], v1[3]);
                        *(v4u*)(merged + (size_t)row * DM + col) = w; }
                    asm volatile("" ::: "memory"); } }
    }
};
struct EpiF32 {
    static constexpr bool PERM = true, AFTER_DRAIN = false;
    float* out; int ldc;
    __device__ __forceinline__ void operator()(const f32x4 (&acc)[2][2][4][2], const pg8::Unit& u, int wr, int wc, int fr, int fq) const {
#pragma unroll
        for (int ai = 0; ai < 2; ++ai)
#pragma unroll
            for (int m = 0; m < 4; ++m) { const int row = u.pm * 256 + ai * 128 + wr * 64 + m * 16 + fr;
#pragma unroll
                for (int bj = 0; bj < 2; ++bj) { const int col = u.pn * 256 + bj * 128 + wc * 32 + 8 * fq;
                    float* p = out + (size_t)row * ldc + col; *(f32x4*)p = acc[ai][bj][m][0]; *(f32x4*)(p + 4) = acc[ai][bj][m][1]; } }
    }
};
struct EpiRelu2 {
    static constexpr bool PERM = true, AFTER_DRAIN = false;
    bf16* out; int ldc;
    __device__ __forceinline__ void operator()(const f32x4 (&acc)[2][2][4][2], const pg8::Unit& u, int wr, int wc, int fr, int fq) const {
#pragma unroll
        for (int ai = 0; ai < 2; ++ai)
#pragma unroll
            for (int m = 0; m < 4; ++m) { const int row = u.pm * 256 + ai * 128 + wr * 64 + m * 16 + fr;
#pragma unroll
                for (int bj = 0; bj < 2; ++bj) { const int col = u.pn * 256 + bj * 128 + wc * 32 + 8 * fq;
                    f32x4 v0 = acc[ai][bj][m][0], v1 = acc[ai][bj][m][1];
#pragma unroll
                    for (int e = 0; e < 4; ++e) { const float a0 = fmaxf(v0[e], 0.f), a1 = fmaxf(v1[e], 0.f); v0[e] = a0 * a0; v1[e] = a1 * a1; }
                    v4u w; w.x = pg8::cvt_pk_bf16(v0[0], v0[1]); w.y = pg8::cvt_pk_bf16(v0[2], v0[3]); w.z = pg8::cvt_pk_bf16(v1[0], v1[1]); w.w = pg8::cvt_pk_bf16(v1[2], v1[3]);
                    *(v4u*)(out + (size_t)row * ldc + col) = w; } }
    }
};

__device__ __forceinline__ void p0_transpose_item(const float* W, int N, bf16* WT, int ldt, LAS float* scr, int item, int lane) {
    const int nblk = N / 32, kb = item / nblk, nb = item % nblk, k0 = 64 * kb, n0 = 32 * nb;
#pragma unroll 8
    for (int i = 0; i < 32; ++i) { const int kk = 2 * i + (lane >> 5); scr[kk * 33 + (lane & 31)] = W[(size_t)(k0 + kk) * N + n0 + (lane & 31)]; }
    asm volatile("s_waitcnt lgkmcnt(0)" ::: "memory");
    const int c = lane & 7;
#pragma unroll
    for (int j = 0; j < 4; ++j) { const int n = (lane >> 3) + 8 * j; const LAS float* s = scr + (8 * c) * 33 + n;
        v4u o; o.x = pk2(s[0 * 33], s[1 * 33]); o.y = pk2(s[2 * 33], s[3 * 33]); o.z = pk2(s[4 * 33], s[5 * 33]); o.w = pk2(s[6 * 33], s[7 * 33]);
        *(v4u*)(WT + (size_t)(n0 + n) * ldt + k0 + 8 * c) = o; }
    asm volatile("s_waitcnt lgkmcnt(0)" ::: "memory");
}
__device__ __forceinline__ void p0_prologue(const Args& a, LAS unsigned char* lds) {
    int tid_ = threadIdx.x; asm volatile("" : "+v"(tid_)); const int tid = tid_, lane = tid & 63, wave = tid >> 6;
    LAS float* scr = (LAS float*)(lds + wave * 16384);
    const int gw = blockIdx.x * NWAVES + wave, NGW = gridDim.x * NWAVES;
    unsigned char* ws = a.ws;
    constexpr int I_IN = (DM / 64) * (IN_W / 32), I_RW = (512 / 64) * (DM / 32), I_O = (DM / 64) * (DM / 32), I_UP = (DM / 64) * (FF / 32), I_DN = (FF / 64) * (DM / 32);
    constexpr int I_L2 = 512 / 32, I_G2 = 2 * (512 / 32);
    constexpr int NITEMS = I_IN + 2 * I_RW + I_O + I_UP + I_DN + 2 * I_L2 + I_G2;
    for (int it = gw; it < NITEMS; it += NGW) {
        int r = it;
        if (r < I_IN) { p0_transpose_item(a.in[2], IN_W, (bf16*)(ws + WS_WIN), DM, scr, r, lane); continue; } r -= I_IN;
        if (r < I_RW) { p0_transpose_item(a.in[14], DM, (bf16*)(ws + WS_WRW), 512, scr, r, lane); continue; } r -= I_RW;
        if (r < I_RW) { p0_transpose_item(a.in[20], DM, (bf16*)(ws + WS_WDA), 512, scr, r, lane); continue; } r -= I_RW;
        if (r < I_O) { p0_transpose_item(a.in[21], DM, (bf16*)(ws + WS_WO), DM, scr, r, lane); continue; } r -= I_O;
        if (r < I_UP) { p0_transpose_item(a.in[24], FF, (bf16*)(ws + WS_WUP), DM, scr, r, lane); continue; } r -= I_UP;
        if (r < I_DN) { p0_transpose_item(a.in[25], DM, (bf16*)(ws + WS_WDN), FF, scr, r, lane); continue; } r -= I_DN;
        if (r < I_L2) { p0_transpose_item(a.in[5], 512, (bf16*)(ws + WS_LORA), 256, scr, r, lane); continue; } r -= I_L2;
        if (r < I_L2) { p0_transpose_item(a.in[7], 512, (bf16*)(ws + WS_LORA) + 512 * 256 + 64, 256, scr, r, lane); continue; } r -= I_L2;
        p0_transpose_item(a.in[8], 512, (bf16*)(ws + WS_LORA) + 1024 * 256 + 128, 256, scr, r, lane);
    }
    for (int ch = blockIdx.x * NTHR + tid; ch < 1536 * 32; ch += gridDim.x * NTHR) {
        const int n = ch >> 5, k0 = (ch & 31) * 8; const int kind = n >> 9;
        const bool nz = (kind == 0) ? (k0 < 64) : (kind == 1 ? (k0 >= 64 && k0 < 128) : (k0 >= 128));
        if (!nz) *(v4u*)((bf16*)(ws + WS_LORA) + (size_t)n * 256 + k0) = (v4u){0u, 0u, 0u, 0u};
    }
    const float* g = a.in[1];
    f32x4 gv[4];
#pragma unroll
    for (int j = 0; j < 4; ++j) gv[j] = *(const f32x4*)(g + 4 * lane + 256 * j);
    for (int m = gw; m < M; m += NGW) {
        const f32x4* xr = (const f32x4*)(a.in[0] + (size_t)m * DM) + lane;
        f32x4 v[4]; float s = 0.f;
#pragma unroll
        for (int j = 0; j < 4; ++j) { v[j] = xr[64 * j]; s += (v[j].x * v[j].x + v[j].y * v[j].y) + (v[j].z * v[j].z + v[j].w * v[j].w); }
        const float rs = 1.0f / sqrtf(wave_sum(s) * (1.f / DM) + 1e-6f);
        v2u* o8 = (v2u*)((bf16*)(ws + WS_XN) + (size_t)m * DM) + lane;
#pragma unroll
        for (int j = 0; j < 4; ++j) { v2u w; w.x = pk2(v[j].x * rs * gv[j].x, v[j].y * rs * gv[j].y); w.y = pk2(v[j].z * rs * gv[j].z, v[j].w * rs * gv[j].w); o8[64 * j] = w; }
    }
}

__device__ __forceinline__ void prep_a(const Args& a) {
    int tid_ = threadIdx.x; asm volatile("" : "+v"(tid_)); const int tid = tid_, lane = tid & 63, wave = tid >> 6;
    const int gw = blockIdx.x * NWAVES + wave, NGW = gridDim.x * NWAVES;
    const bf16* zrw = (const bf16*)(a.ws + WS_ZRW); bf16* T = (bf16*)(a.ws + WS_XN);
    const int c = 4 * lane; const f32x4 mu = *(const f32x4*)(a.in[3] + 1536 + c);
    for (int t = gw; t < M; t += NGW) {
        const v2u cur = *(const v2u*)(zrw + (size_t)t * RW_IN + 1536 + c);
        v2u prv = (v2u){0u, 0u}; if ((t & (SEQ - 1)) != 0) prv = *(const v2u*)(zrw + (size_t)(t - 1) * RW_IN + 1536 + c);
        float u[4]; const float zc[4] = {bflo(cur.x), bfhi(cur.x), bflo(cur.y), bfhi(cur.y)}, zp[4] = {bflo(prv.x), bfhi(prv.x), bflo(prv.y), bfhi(prv.y)};
#pragma unroll
        for (int e = 0; e < 4; ++e) { const float x = zc[e] + (zp[e] - zc[e]) * mu[e];
            u[e] = (c < 64) ? tanhf(x) : ((c < 128) ? x : 1.0f / (1.0f + expf(-x))); }
        v2u w; w.x = pk2(u[0], u[1]); w.y = pk2(u[2], u[3]);
        *(v2u*)(T + (size_t)t * 256 + c) = w;
    }
}

__device__ __forceinline__ float lerp_col(const bf16* zrw, int t, int col, float mu) {
    const float zc = bf2f(zrw[(size_t)t * RW_IN + col]);
    const float zp = ((t & (SEQ - 1)) != 0) ? bf2f(zrw[(size_t)(t - 1) * RW_IN + col]) : 0.f;
    return zc + (zp - zc) * mu;
}

__device__ __forceinline__ void scan_naive(const Args& a, LAS unsigned char* lds) {
    int tid_ = threadIdx.x; asm volatile("" : "+v"(tid_)); const int tid = tid_, lane = tid & 63, h = tid >> 6; const int b = blockIdx.x;
    const bf16* zrw = (const bf16*)(a.ws + WS_ZRW);
    const bf16* DEC = (const bf16*)((unsigned char*)a.out + DO_DEC); const bf16* AV = (const bf16*)((unsigned char*)a.out + DO_A);
    bf16* YR = (bf16*)((unsigned char*)a.out + DO_YRAW);
    LAS float* L = (LAS float*)lds + h * 320;
    const int col = h * 64 + lane;
    const float mu_r = a.in[3][col], mu_k = a.in[3][512 + col], mu_v = a.in[3][1024 + col];
    const float kkc = a.in[9][col], kac = a.in[10][col];
    float S[64];
#pragma unroll
    for (int j = 0; j < 64; ++j) S[j] = 0.f;
    for (int tt = 0; tt < SEQ; ++tt) {
        const int t = b * SEQ + tt;
        const float r = lerp_col(zrw, t, col, mu_r), k = lerp_col(zrw, t, 512 + col, mu_k), v = lerp_col(zrw, t, 1024 + col, mu_v);
        const float dec = 0.5f + (float)DEC[(size_t)t * 512 + col] * (1.0f / 131070.0f);
        const float av = bf2f(AV[(size_t)t * 512 + col]);
        const float kkr = k * kkc; const float n2 = wave_sum(kkr * kkr); const float kk = kkr / fmaxf(sqrtf(n2), 1e-12f);
        const float kp = k * (1.0f + (av - 1.0f) * kac);
        __syncthreads();
        L[lane] = dec; L[64 + lane] = kk; L[128 + lane] = kk * av; L[192 + lane] = kp; L[256 + lane] = r;
        __syncthreads();
        float sa = 0.f;
#pragma unroll
        for (int j = 0; j < 64; j += 4) { const f32x4 q = *(const LAS f32x4*)(L + 64 + j); sa += S[j] * q[0] + S[j + 1] * q[1] + S[j + 2] * q[2] + S[j + 3] * q[3]; }
        sa = -sa; float y = 0.f;
#pragma unroll
        for (int j = 0; j < 64; j += 4) { const f32x4 w = *(const LAS f32x4*)(L + j), bb = *(const LAS f32x4*)(L + 128 + j), kq = *(const LAS f32x4*)(L + 192 + j), rq = *(const LAS f32x4*)(L + 256 + j);
#pragma unroll
            for (int e = 0; e < 4; ++e) { S[j + e] = S[j + e] * w[e] + sa * bb[e] + v * kq[e]; y += S[j + e] * rq[e]; } }
        YR[(size_t)t * 512 + col] = (bf16)f2bf(y);
    }
}

__device__ __forceinline__ float block_max(float v, LAS float* red, int tid) {
    v = wave_max(v); __syncthreads(); if ((tid & 63) == 0) red[tid >> 6] = v; __syncthreads();
    float r = red[0];
#pragma unroll
    for (int i = 1; i < 8; ++i) r = fmaxf(r, red[i]);
    return r;
}
__device__ __forceinline__ float block_sum(float v, LAS float* red, int tid) {
    v = wave_sum(v); __syncthreads(); if ((tid & 63) == 0) red[tid >> 6] = v; __syncthreads();
    float r = red[0];
#pragma unroll
    for (int i = 1; i < 8; ++i) r += red[i];
    return r;
}
__device__ __forceinline__ void attn_naive(const Args& a, LAS unsigned char* lds, int first_blk) {
    int tid_ = threadIdx.x; asm volatile("" : "+v"(tid_)); const int tid = tid_;
    LAS float* sc = (LAS float*)lds;
    LAS float* red = (LAS float*)(lds + 65536);
    LAS float* op = (LAS float*)(lds + 65536 + 256);
    const bf16* zda = (const bf16*)(a.ws + WS_ZDA); bf16* dao = (bf16*)(a.ws + WS_DAO);
    float lam; { float s1 = 0.f, s2 = 0.f;
#pragma unroll 1
        for (int i = 0; i < 64; ++i) { s1 += a.in[15][i] * a.in[16][i]; s2 += a.in[17][i] * a.in[18][i]; } lam = expf(s1) - expf(s2) + LAMBDA_INIT; }
    const int nb = gridDim.x - first_blk;
    for (int unit = blockIdx.x - first_blk; unit < BATCH * 4 * SEQ; unit += nb) {
        const int t = unit & (SEQ - 1), h = (unit >> 13) & 3, b = unit >> 15;
        const size_t rowb = (size_t)b * SEQ; const int kend = ((t >> 6) + 1) << 6;
        float lsum[2];
#pragma unroll
        for (int m = 0; m < 2; ++m) {
            LAS float* qs = (LAS float*)(lds + 65536 + 8192);
            __syncthreads();
            if (tid < 64) qs[tid] = bf2f(zda[(rowb + t) * DA_IN + (h * 2 + m) * 64 + tid]);
            __syncthreads();
            float lmax = -INFINITY;
#pragma unroll 1
            for (int key = tid; key < kend; key += NTHR) {
                const v4u* kp = (const v4u*)(zda + (rowb + key) * DA_IN + 512 + (h * 2 + m) * 64); float s = 0.f;
#pragma unroll
                for (int c = 0; c < 8; ++c) { const v4u w = kp[c]; const f32x4 qa = *(const LAS f32x4*)(qs + 8 * c), qb = *(const LAS f32x4*)(qs + 8 * c + 4);
                    s += qa[0] * bflo(w.x) + qa[1] * bfhi(w.x) + qa[2] * bflo(w.y) + qa[3] * bfhi(w.y) + qb[0] * bflo(w.z) + qb[1] * bfhi(w.z) + qb[2] * bflo(w.w) + qb[3] * bfhi(w.w); }
                sc[m * SEQ + key] = s; lmax = fmaxf(lmax, s);
            }
            const float mx = block_max(lmax, red, tid);
            float ls = 0.f;
#pragma unroll 1
            for (int key = tid; key < kend; key += NTHR) { const float p = exp2f(sc[m * SEQ + key] - mx); sc[m * SEQ + key] = p; ls += p; }
            lsum[m] = block_sum(ls, red, tid);
        }
        __syncthreads();
        const int d = tid & 127, part = tid >> 7; float o1 = 0.f, o2 = 0.f;
        const bf16* vp = zda + rowb * DA_IN + 1024 + h * 128 + d;
#pragma unroll 2
        for (int key = part; key < kend; key += 4) { const float v = bf2f(vp[(size_t)key * DA_IN]); o1 += sc[key] * v; o2 += sc[SEQ + key] * v; }
        op[(part * 2 + 0) * 128 + d] = o1; op[(part * 2 + 1) * 128 + d] = o2;
        __syncthreads();
        float o = 0.f;
        if (tid < 128) { const float O1 = (op[d] + op[256 + d] + op[512 + d] + op[768 + d]) / lsum[0], O2 = (op[128 + d] + op[384 + d] + op[640 + d] + op[896 + d]) / lsum[1]; o = O1 - lam * O2; }
        const float ss = block_sum(o * o, red, tid);
        if (tid < 128) dao[(rowb + t) * 512 + h * 128 + d] = (bf16)f2bf(o * (1.0f / sqrtf(ss * (1.0f / 128.0f) + 1e-5f)) * a.in[19][d] * (1.0f - LAMBDA_INIT));
        __syncthreads();
    }
}

__device__ __forceinline__ void post_rw(const Args& a) {
    int tid_ = threadIdx.x; asm volatile("" : "+v"(tid_)); const int tid = tid_, lane = tid & 63, wave = tid >> 6;
    const int gw = blockIdx.x * NWAVES + wave, NGW = gridDim.x * NWAVES;
    const bf16* zrw = (const bf16*)(a.ws + WS_ZRW);
    const bf16* AV = (const bf16*)((unsigned char*)a.out + DO_A); const bf16* GV = (const bf16*)((unsigned char*)a.out + DO_G);
    const bf16* YR = (const bf16*)((unsigned char*)a.out + DO_YRAW); bf16* RWO = (bf16*)((unsigned char*)a.out + DO_RWO);
    for (int unit = gw; unit < M * 8; unit += NGW) {
        const int t = unit >> 3, h = unit & 7, col = h * 64 + lane;
        const float y = bf2f(YR[(size_t)t * 512 + col]);
        const float mean = wave_sum(y) * (1.f / 64.f); const float dy = y - mean; const float var = wave_sum(dy * dy) * (1.f / 64.f);
        const float yn = dy * (1.0f / sqrtf(var + 64e-5f)) * a.in[12][col] + a.in[13][col];
        const float r = lerp_col(zrw, t, col, a.in[3][col]), k = lerp_col(zrw, t, 512 + col, a.in[3][512 + col]), v = lerp_col(zrw, t, 1024 + col, a.in[3][1024 + col]);
        const float av = bf2f(AV[(size_t)t * 512 + col]); const float kp = k * (1.0f + (av - 1.0f) * a.in[10][col]);
        const float rkb = wave_sum(r * kp * a.in[11][col]);
        const float o = (yn + rkb * v) * bf2f(GV[(size_t)t * 512 + col]);
        RWO[(size_t)t * 512 + col] = (bf16)f2bf(o);
    }
}

__device__ __forceinline__ void rows1(const Args& a) {
    int tid_ = threadIdx.x; asm volatile("" : "+v"(tid_)); const int tid = tid_, lane = tid & 63, wave = tid >> 6;
    const int gw = blockIdx.x * NWAVES + wave, NGW = gridDim.x * NWAVES;
    const float* Y = (const float*)(a.ws + WS_Y); bf16* H2 = (bf16*)(a.ws + WS_XN);
    for (int m = gw; m < M; m += NGW) {
        const f32x4* yr = (const f32x4*)(Y + (size_t)m * DM) + lane; const f32x4* xr = (const f32x4*)(a.in[0] + (size_t)m * DM) + lane;
        f32x4 v[4]; float s = 0.f;
#pragma unroll
        for (int j = 0; j < 4; ++j) { v[j] = yr[64 * j]; s += (v[j].x * v[j].x + v[j].y * v[j].y) + (v[j].z * v[j].z + v[j].w * v[j].w); }
        const float rs = 1.0f / sqrtf(wave_sum(s) * (1.f / DM) + 1e-6f); float s2 = 0.f;
#pragma unroll
        for (int j = 0; j < 4; ++j) { const f32x4 g = *(const f32x4*)(a.in[22] + 4 * lane + 256 * j); v[j] = xr[64 * j] + v[j] * rs * g; s2 += (v[j].x * v[j].x + v[j].y * v[j].y) + (v[j].z * v[j].z + v[j].w * v[j].w); }
        const float rs2 = 1.0f / sqrtf(wave_sum(s2) * (1.f / DM) + 1e-6f);
        f32x4* orow = (f32x4*)(a.out + (size_t)m * DM) + lane; v2u* h8 = (v2u*)(H2 + (size_t)m * DM) + lane;
#pragma unroll
        for (int j = 0; j < 4; ++j) { orow[64 * j] = v[j]; const f32x4 g = *(const f32x4*)(a.in[23] + 4 * lane + 256 * j);
            v2u w; w.x = pk2(v[j].x * rs2 * g.x, v[j].y * rs2 * g.y); w.y = pk2(v[j].z * rs2 * g.z, v[j].w * rs2 * g.w); h8[64 * j] = w; }
    }
}
__device__ __forceinline__ void rows2(const Args& a) {
    int tid_ = threadIdx.x; asm volatile("" : "+v"(tid_)); const int tid = tid_, lane = tid & 63, wave = tid >> 6;
    const int gw = blockIdx.x * NWAVES + wave, NGW = gridDim.x * NWAVES;
    const float* F = (const float*)(a.ws + WS_F);
    for (int m = gw; m < M; m += NGW) {
        const f32x4* fr = (const f32x4*)(F + (size_t)m * DM) + lane; f32x4* orow = (f32x4*)(a.out + (size_t)m * DM) + lane;
        f32x4 v[4]; float s = 0.f;
#pragma unroll
        for (int j = 0; j < 4; ++j) { v[j] = fr[64 * j]; s += (v[j].x * v[j].x + v[j].y * v[j].y) + (v[j].z * v[j].z + v[j].w * v[j].w); }
        const float rs = 1.0f / sqrtf(wave_sum(s) * (1.f / DM) + 1e-6f);
#pragma unroll
        for (int j = 0; j < 4; ++j) { const f32x4 g = *(const f32x4*)(a.in[26] + 4 * lane + 256 * j); orow[64 * j] = orow[64 * j] + v[j] * rs * g; }
    }
}

constexpr int NPH = 12;
template <int LO, int HI> __global__ void __launch_bounds__(NTHR, 2) mk_fwd(Args a) {
    extern __shared__ __attribute__((aligned(16))) unsigned char lds_raw[];
    LAS unsigned char* lds = (LAS unsigned char*)lds_raw;
    unsigned char* ws = a.ws;
    const int G = gridDim.x, c = blockIdx.x;
    constexpr int lo = LO, hi = HI;
#ifdef ONLY_PH
#define IN(k) ((k) == ONLY_PH && lo <= (k) && (k) < hi)
#else
#define IN(k) (lo <= (k) && (k) < hi)
#endif
#define SEAM(k) do { __syncthreads(); if ((k) + 1 < hi) cg::this_grid().sync(); } while (0)
    if (IN(0)) { p0_prologue(a, lds); SEAM(0); }
    if (IN(1)) { pg8::Gemm g{(const bf16*)(ws + WS_XN), (const bf16*)(ws + WS_WIN), M, IN_W, DM}; pg8::StaticOrder S; S.init(M, IN_W, G, c);
        EpiG1 E{(bf16*)(ws + WS_ZRW), (bf16*)(ws + WS_ZDA), (bf16*)(ws + WS_ZG)};
        pg8::gemm_phase<EpiG1, pg8::StaticOrder, true, true>(lds, g, S, E); SEAM(1); }
    if (IN(2)) { prep_a(a); SEAM(2); }
    if (IN(3)) { int k3 = 256; asm volatile("" : "+s"(k3)); pg8::Gemm g{(const bf16*)(ws + WS_XN), (const bf16*)(ws + WS_LORA), M, 1536, k3}; pg8::StaticOrder S; S.init(M, 1536, G, c);
        EpiLora E{(bf16*)((unsigned char*)a.out + DO_DEC), (bf16*)((unsigned char*)a.out + DO_A), (bf16*)((unsigned char*)a.out + DO_G), a.in[4], a.in[6]};
        pg8::gemm_phase<EpiLora, pg8::StaticOrder, true, true>(lds, g, S, E); SEAM(3); }
    if (IN(4)) { if (c < 2) scan_naive(a, lds); else attn_naive(a, lds, 2); SEAM(4); }
    if (IN(5)) { post_rw(a); SEAM(5); }
    if (IN(6)) { pg8::StaticOrder S; S.init(M, DM, G, c);
        { pg8::Gemm g{(const bf16*)((unsigned char*)a.out + DO_RWO), (const bf16*)(ws + WS_WRW), M, DM, 512};
          EpiGate<0> E{(const bf16*)(ws + WS_ZG), 0, (float*)(ws + WS_Y), (bf16*)(ws + WS_MERGED)};
          pg8::gemm_phase<EpiGate<0>, pg8::StaticOrder, true, true>(lds, g, S, E); }
        __syncthreads();
        { pg8::Gemm g{(const bf16*)(ws + WS_DAO), (const bf16*)(ws + WS_WDA), M, DM, 512};
          EpiGate<1> E{(const bf16*)(ws + WS_ZG), DM, (float*)(ws + WS_Y), (bf16*)(ws + WS_MERGED)};
          pg8::gemm_phase<EpiGate<1>, pg8::StaticOrder, true, true>(lds, g, S, E); }
        SEAM(6); }
    if (IN(7)) { pg8::Gemm g{(const bf16*)(ws + WS_MERGED), (const bf16*)(ws + WS_WO), M, DM, DM}; pg8::StaticOrder S; S.init(M, DM, G, c);
        EpiF32 E{(float*)(ws + WS_Y), DM};
        pg8::gemm_phase<EpiF32, pg8::StaticOrder, true, true>(lds, g, S, E); SEAM(7); }
    if (IN(8)) { rows1(a); SEAM(8); }
    if (IN(9)) { pg8::Gemm g{(const bf16*)(ws + WS_XN), (const bf16*)(ws + WS_WUP), M, FF, DM}; pg8::StaticOrder S; S.init(M, FF, G, c);
        EpiRelu2 E{(bf16*)(ws + WS_H), FF};
        pg8::gemm_phase<EpiRelu2, pg8::StaticOrder, true, true>(lds, g, S, E); SEAM(9); }
    if (IN(10)) { pg8::Gemm g{(const bf16*)(ws + WS_H), (const bf16*)(ws + WS_WDN), M, DM, FF}; pg8::StaticOrder S; S.init(M, DM, G, c);
        EpiF32 E{(float*)(ws + WS_F), DM};
        pg8::gemm_phase<EpiF32, pg8::StaticOrder, true, true>(lds, g, S, E); SEAM(10); }
    if (IN(11)) { rows2(a); }
#undef IN
#undef SEAM
}

#ifndef MK_ONE_LAUNCH
#define MK_ONE_LAUNCH 0
#endif
template <int PH> static void launch_phases(const Args& a, int grid, hipStream_t stream) {
    hipLaunchKernelGGL((mk_fwd<PH, PH + 1>), dim3(grid), dim3(NTHR), LDS_BYTES, stream, a);
    if constexpr (PH + 1 < NPH) launch_phases<PH + 1>(a, grid, stream);
}
template <int PH> static bool set_lds_attr() {
    bool ok = hipFuncSetAttribute((const void*)mk_fwd<PH, PH + 1>, hipFuncAttributeMaxDynamicSharedMemorySize, LDS_BYTES) == hipSuccess;
    if constexpr (PH + 1 < NPH) ok = set_lds_attr<PH + 1>() && ok;
    return ok;
}
extern "C" void kernel_launch(void* const* d_in, const int* in_sizes, int n_in, void* d_out, int out_size, void* d_ws, size_t ws_size, hipStream_t stream) {
    static int grid = 0;
    if (grid == 0) {
        if (n_in != 27 || in_sizes[0] != M * DM || out_size != M * DM || ws_size < WS_END) { fprintf(stderr, "kernel_launch: unexpected shapes: n_in %d in0 %d out %d ws %zu\n", n_in, n_in > 0 ? in_sizes[0] : -1, out_size, ws_size); grid = -1; return; }
        int dev = 0, cus = 0;
        (void)hipGetDevice(&dev); (void)hipDeviceGetAttribute(&cus, hipDeviceAttributeMultiprocessorCount, dev);
#if MK_ONE_LAUNCH
        bool ok = hipFuncSetAttribute((const void*)mk_fwd<0, NPH>, hipFuncAttributeMaxDynamicSharedMemorySize, LDS_BYTES) == hipSuccess;
#else
        bool ok = set_lds_attr<0>();
#endif
        if (!ok) { fprintf(stderr, "kernel_launch: hipFuncSetAttribute failed\n"); grid = -1; return; }
        grid = cus;
    }
    if (grid < 0) return;
    Args a{};
    for (int i = 0; i < 27; ++i) a.in[i] = (const float*)d_in[i];
    a.out = (float*)d_out; a.ws = (unsigned char*)d_ws;
#if MK_ONE_LAUNCH
    void* args[] = {&a};
    hipError_t e = hipLaunchCooperativeKernel((const void*)mk_fwd<0, NPH>, dim3(grid), dim3(NTHR), args, LDS_BYTES, stream);
    if (e != hipSuccess) fprintf(stderr, "cooperative launch failed: %s (grid %d)\n", hipGetErrorString(e), grid);
#else
    launch_phases<0>(a, grid, stream);
#endif
}
```

```cpp
#include <hip/hip_runtime.h>
#include <hip/hip_cooperative_groups.h>
#include <cstdio>
#include <cstdint>
#include <cmath>
namespace cg = cooperative_groups;
namespace pg8 {
#define PG8_LAS __attribute__((address_space(3)))
typedef unsigned short bf16_t;
typedef short bf16x8 __attribute__((ext_vector_type(8)));
typedef float f32x4 __attribute__((ext_vector_type(4)));
typedef unsigned u32x4 __attribute__((ext_vector_type(4)));
constexpr int BM = 256, BK = 64, HALF = 128, HTB = HALF * BK * 2  , STAGE_BYTES = 8 * HTB, NXCD = 8, WGM = 8;

__host__ __device__ __forceinline__ int lds_byte(int r, int c) { const int st = (r >> 4) * 2 + (c >> 5), rr = r & 15, cc = c & 31, ob = rr * 64 + cc * 2; return st * 1024 + (ob ^ (((ob >> 9) & 1) << 5)); }
__host__ __device__ __forceinline__ void stage_rc(int b, int& R, int& C) { const int st = b / 1024, sb = b % 1024, swz = sb ^ (((sb >> 9) & 1) << 5); R = (st >> 1) * 16 + swz / 64; C = (st & 1) * 32 + (swz % 64) / 2; }
__host__ __device__ __forceinline__ int perm32(int rho) { const int n = rho >> 4, i = rho & 15; return 8 * (i >> 2) + 4 * n + (i & 3); }

struct Unit { int pm, pn; };
struct Gemm { const bf16_t* A; const bf16_t* Bt; int M, N, K; };

struct StaticOrder {
    int nM, nN, nwg, G, c;
    __host__ __device__ void init(int M, int N, int G_, int c_) { nM = M / BM; nN = N / BM; nwg = nM * nN; G = G_; c = c_; }
    __host__ __device__ bool next(int i, Unit& u) const {
        const long L = (long)i * G + c; if (L >= nwg) return false;
        int wgid = (int)L; { const int q = nwg / NXCD, r = nwg % NXCD, xcd = wgid % NXCD, off = wgid / NXCD; wgid = (xcd < r ? xcd * (q + 1) : r * (q + 1) + (xcd - r) * q) + off; }
        const int nig = WGM * nN, gid = wgid / nig, fm = gid * WGM, gsz = (nM - fm) < WGM ? (nM - fm) : WGM;
        u.pm = fm + ((wgid % nig) % gsz); u.pn = (wgid % nig) / gsz; return true;
    }
    __device__ __forceinline__ void a_ready(const Unit&) const {}
    __device__ __forceinline__ void done(const Unit&) const {}
};

__device__ __forceinline__ unsigned cvt_pk_bf16(float lo, float hi) { unsigned r; asm volatile("v_cvt_pk_bf16_f32 %0, %1, %2" : "=v"(r) : "v"(lo), "v"(hi)); return r; }
typedef float f32x2 __attribute__((ext_vector_type(2)));
__device__ __forceinline__ f32x2 gelu_pk(f32x2 v) {
    const f32x2 av = __builtin_elementwise_abs(v), d = av * 0.2316418882f + 1.0f;
    f32x2 t; t.x = __builtin_amdgcn_rcpf(d.x); t.y = __builtin_amdgcn_rcpf(d.y);
    f32x2 q = t * 0.5307027145f + (-0.7265760135f); q = q * t + 0.7107068705f; q = q * t + (-0.142248368f); q = q * t + 0.127414796f; q = q * t;
    const f32x2 s = (v * v) * (-0.72134752044f);
    f32x2 e; e.x = __builtin_amdgcn_exp2f(s.x); e.y = __builtin_amdgcn_exp2f(s.y);
    const f32x2 m = v * (q * e), r = v - m;
    f32x2 o; o.x = v.x < 0.f ? m.x : r.x; o.y = v.y < 0.f ? m.y : r.y; return o;
}

template <int ACT  > struct EpiBf16 {
    static constexpr bool PERM = true, AFTER_DRAIN = false; static_assert(ACT == 0 || ACT == 1, "EpiBf16: ACT is 0 (none) or 1 (gelu_pk)");
    bf16_t* O; int ldc; const float* bias; int split_cols; size_t split_stride; float scale0;
    __device__ __forceinline__ void operator()(const f32x4 (&acc)[2][2][4][2], const Unit& u, int wr, int wc, int fr, int fq) const {
        const int row0 = u.pm * BM + wr * 64 + fr; int colt = u.pn * BM; bf16_t* base = O;
        float sc = 1.f; if (split_cols) { const int t = colt / split_cols; base += (size_t)t * split_stride; colt -= t * split_cols; if (t == 0) sc = scale0; }
        const int col0 = colt + wc * 32 + 8 * fq, bcol0 = u.pn * BM + wc * 32 + 8 * fq;
        f32x4 bv[2][2];
#pragma unroll
        for (int bj = 0; bj < 2; ++bj)
#pragma unroll
            for (int n = 0; n < 2; ++n) bv[bj][n] = bias ? *(const f32x4*)(bias + bcol0 + bj * HALF + 4 * n) : (f32x4){0.f, 0.f, 0.f, 0.f};
#pragma unroll
        for (int ai = 0; ai < 2; ++ai)
#pragma unroll
            for (int m = 0; m < 4; ++m) { bf16_t* rowp = base + (size_t)(row0 + ai * HALF + m * 16) * ldc + col0;
#pragma unroll
                for (int bj = 0; bj < 2; ++bj) { f32x4 v0 = acc[ai][bj][m][0] + bv[bj][0], v1 = acc[ai][bj][m][1] + bv[bj][1];
                    if (ACT == 1) { f32x2 a = gelu_pk((f32x2){v0[0], v0[1]}), b = gelu_pk((f32x2){v0[2], v0[3]}), c = gelu_pk((f32x2){v1[0], v1[1]}), d = gelu_pk((f32x2){v1[2], v1[3]});
                        v0 = (f32x4){a.x, a.y, b.x, b.y}; v1 = (f32x4){c.x, c.y, d.x, d.y}; }
                    v0 = v0 * sc; v1 = v1 * sc; u32x4 w; w.x = cvt_pk_bf16(v0[0], v0[1]); w.y = cvt_pk_bf16(v0[2], v0[3]); w.z = cvt_pk_bf16(v1[0], v1[1]); w.w = cvt_pk_bf16(v1[2], v1[3]);
                    *(u32x4*)(rowp + bj * HALF) = w; } }
    }
};

template <class Epi, class Sched, bool ALIGN_EPI = false, bool SP2 = false>
__device__ __forceinline__ void gemm_phase(PG8_LAS unsigned char* lds, const Gemm g, const Sched& S, const Epi& E) {
    int tid_ = threadIdx.x; asm volatile("" : "+v"(tid_));
    const int tid = tid_, wid = __builtin_amdgcn_readfirstlane(tid >> 6), lane = tid & 63, wr = wid >> 2, wc = wid & 3, fr = lane & 15, fq = lane >> 4;
    const int K = g.K, nt = K / BK;
    unsigned voffA[2], voffB[2];
#pragma unroll
    for (int i = 0; i < 2; ++i) { int R, C; stage_rc(tid * 16 + i * 8192, R, C); const int Rb = Epi::PERM ? ((R & ~31) + perm32(R & 31)) : R;
        voffA[i] = (unsigned)(R * K + C) * 2u; voffB[i] = (unsigned)(Rb * K + C) * 2u; }
    const size_t kstep = (size_t)(BK * 2);
    const size_t hstep = (size_t)HALF * K * 2;
    const size_t tstep = 2 * hstep;
    const unsigned ldsw = (unsigned)wid * 1024u;
    const int aoff = lds_byte(wr * 64 + fr, fq * 8), boff = lds_byte(wc * 32 + fr, fq * 8);
#define PG8_SA(b, h) (((b) * 2 + (h)) * HTB)
#define PG8_SB(b, h) ((4 + (b) * 2 + (h)) * HTB)
#define PG8_STAGE(bufoff, gbase, voff) do { _Pragma("unroll") for (int _i = 0; _i < 2; ++_i) \
        __builtin_amdgcn_global_load_lds((const unsigned*)((const char*)(gbase) + (voff)[_i]), (PG8_LAS unsigned*)(lds + (bufoff) + ldsw + _i * 8192), 16, 0, 0); } while (0)
#define PG8_LDA(dst, b, h) do { _Pragma("unroll") for (int m = 0; m < 4; ++m) _Pragma("unroll") for (int k = 0; k < 2; ++k) dst[m][k] = *(const PG8_LAS bf16x8*)(lds + PG8_SA(b, h) + aoff + m * 2048 + k * 1024); } while (0)
#define PG8_LDB(dst, b, h) do { _Pragma("unroll") for (int n = 0; n < 2; ++n) _Pragma("unroll") for (int k = 0; k < 2; ++k) dst[n][k] = *(const PG8_LAS bf16x8*)(lds + PG8_SB(b, h) + boff + n * 2048 + k * 1024); } while (0)
#define PG8_MMA(ai, bj, At, Bt) do { __builtin_amdgcn_s_setprio(1); _Pragma("unroll") for (int m = 0; m < 4; ++m) _Pragma("unroll") for (int n = 0; n < 2; ++n) _Pragma("unroll") for (int k = 0; k < 2; ++k) \
        acc[ai][bj][m][n] = __builtin_amdgcn_mfma_f32_16x16x32_bf16(Bt[n][k], At[m][k], acc[ai][bj][m][n], 0, 0, 0); __builtin_amdgcn_s_setprio(0); } while (0)
#define PG8_WAIT_V(n) asm volatile("s_waitcnt vmcnt(" #n ")" ::: "memory")
#define PG8_WAIT_L(n) asm volatile("s_waitcnt lgkmcnt(" #n ")" ::: "memory")
#define PG8_BAR __builtin_amdgcn_s_barrier()
#define PG8_SCHED __builtin_amdgcn_sched_barrier(0)
    Unit cur, nxt; int ui = 0;
    if (!S.next(0, cur)) return;
    f32x4 acc[2][2][4][2];
#pragma unroll
    for (int a = 0; a < 2; ++a)
#pragma unroll
        for (int b = 0; b < 2; ++b)
#pragma unroll
            for (int m = 0; m < 4; ++m)
#pragma unroll
                for (int n = 0; n < 2; ++n) acc[a][b][m][n] = (f32x4){0.f, 0.f, 0.f, 0.f};
    bf16x8 At[4][2], B0[2][2], B1[2][2];
    const char* cA = (const char*)g.A + (size_t)cur.pm * tstep; const char* cB = (const char*)g.Bt + (size_t)cur.pn * tstep;
    S.a_ready(cur);
    if constexpr (SP2) {
        PG8_STAGE(PG8_SB(0, 0), cB, voffB); PG8_STAGE(PG8_SB(0, 1), cB + hstep, voffB); PG8_STAGE(PG8_SA(0, 0), cA, voffA); PG8_STAGE(PG8_SA(0, 1), cA + hstep, voffA);
        if (wr == 1) PG8_BAR;
        PG8_WAIT_V(2); PG8_BAR;
        PG8_STAGE(PG8_SB(1, 0), cB + kstep, voffB); PG8_STAGE(PG8_SA(1, 0), cA + kstep, voffA); PG8_STAGE(PG8_SB(1, 1), cB + hstep + kstep, voffB);
        PG8_WAIT_V(6); PG8_BAR;
    } else {
        PG8_STAGE(PG8_SB(0, 0), cB, voffB); PG8_STAGE(PG8_SA(0, 0), cA, voffA); PG8_STAGE(PG8_SB(0, 1), cB + hstep, voffB); PG8_STAGE(PG8_SA(0, 1), cA + hstep, voffA);
        if (wr == 1) PG8_BAR;
        PG8_WAIT_V(4); PG8_BAR;
        PG8_STAGE(PG8_SB(1, 0), cB + kstep, voffB); PG8_STAGE(PG8_SA(1, 0), cA + kstep, voffA); PG8_STAGE(PG8_SB(1, 1), cB + hstep + kstep, voffB);
        PG8_WAIT_V(6); PG8_BAR;
    }
    for (;;) {
        const bool has_next = S.next(ui + 1, nxt);
        const char* nA = has_next ? (const char*)g.A + (size_t)nxt.pm * tstep : cA; const char* nB = has_next ? (const char*)g.Bt + (size_t)nxt.pn * tstep : cB;
        for (int t = 0; t < nt; t += 2) {
            const bool last = (t == nt - 2);
            const char* a1 = cA + (size_t)(t + 1) * kstep;
            const char* a2 = last ? nA : cA + (size_t)(t + 2) * kstep; const char* b2 = last ? nB : cB + (size_t)(t + 2) * kstep;
            const char* a3 = a2 + kstep; const char* b3 = b2 + kstep;
            if (last && has_next) S.a_ready(nxt);
            if constexpr (SP2) {
            PG8_LDB(B0, 0, 0); PG8_LDB(B1, 0, 1); PG8_SCHED; PG8_LDA(At, 0, 0); PG8_STAGE(PG8_SA(1, 1), a1 + hstep, voffA);
            PG8_WAIT_V(8); PG8_WAIT_L(0); PG8_BAR; PG8_MMA(0, 0, At, B0); PG8_MMA(0, 1, At, B1); PG8_BAR; PG8_SCHED;
            PG8_LDA(At, 0, 1); PG8_STAGE(PG8_SB(0, 0), b2, voffB); PG8_STAGE(PG8_SB(0, 1), b2 + hstep, voffB); PG8_STAGE(PG8_SA(0, 0), a2, voffA);
            PG8_WAIT_V(8); PG8_WAIT_L(0); PG8_BAR; PG8_MMA(1, 0, At, B0); PG8_MMA(1, 1, At, B1); PG8_BAR; PG8_SCHED;
            PG8_LDB(B0, 1, 0); PG8_LDB(B1, 1, 1); PG8_SCHED; PG8_LDA(At, 1, 0); PG8_STAGE(PG8_SA(0, 1), a2 + hstep, voffA);
            PG8_WAIT_V(8); PG8_WAIT_L(0); PG8_BAR; PG8_MMA(0, 0, At, B0); PG8_MMA(0, 1, At, B1); PG8_BAR; PG8_SCHED;
            PG8_LDA(At, 1, 1); PG8_STAGE(PG8_SB(1, 0), b3, voffB); PG8_STAGE(PG8_SB(1, 1), b3 + hstep, voffB); PG8_STAGE(PG8_SA(1, 0), a3, voffA);
            PG8_WAIT_V(8); PG8_WAIT_L(0); PG8_BAR; PG8_MMA(1, 0, At, B0); PG8_MMA(1, 1, At, B1); PG8_BAR; PG8_SCHED;
            } else {
            PG8_LDB(B0, 0, 0); PG8_SCHED; PG8_LDA(At, 0, 0); PG8_STAGE(PG8_SA(1, 1), a1 + hstep, voffA);
            PG8_WAIT_L(8); PG8_BAR; PG8_WAIT_L(0); PG8_MMA(0, 0, At, B0); PG8_BAR; PG8_SCHED;
            PG8_LDB(B1, 0, 1); PG8_STAGE(PG8_SB(0, 0), b2, voffB);
            PG8_BAR; PG8_WAIT_L(0); PG8_MMA(0, 1, At, B1); PG8_BAR;
            PG8_LDA(At, 0, 1); PG8_STAGE(PG8_SA(0, 0), a2, voffA);
            PG8_BAR; PG8_WAIT_L(0); PG8_MMA(1, 0, At, B0); PG8_BAR; PG8_SCHED;
            PG8_STAGE(PG8_SB(0, 1), b2 + hstep, voffB);
            PG8_WAIT_V(6); PG8_BAR; PG8_MMA(1, 1, At, B1); PG8_BAR;
            PG8_LDB(B0, 1, 0); PG8_SCHED; PG8_LDA(At, 1, 0); PG8_STAGE(PG8_SA(0, 1), a2 + hstep, voffA);
            PG8_WAIT_L(8); PG8_BAR; PG8_WAIT_L(0); PG8_MMA(0, 0, At, B0); PG8_BAR; PG8_SCHED;
            PG8_LDB(B1, 1, 1); PG8_STAGE(PG8_SB(1, 0), b3, voffB);
            PG8_BAR; PG8_WAIT_L(0); PG8_MMA(0, 1, At, B1); PG8_BAR;
            PG8_LDA(At, 1, 1); PG8_STAGE(PG8_SA(1, 0), a3, voffA);
            PG8_BAR; PG8_WAIT_L(0); PG8_MMA(1, 0, At, B0); PG8_BAR; PG8_SCHED;
            PG8_STAGE(PG8_SB(1, 1), b3 + hstep, voffB);
            PG8_WAIT_V(6); PG8_BAR; PG8_MMA(1, 1, At, B1); PG8_BAR;
            }
        }
        if constexpr (ALIGN_EPI) { if (wr == 0) PG8_BAR; }
        if constexpr (!Epi::AFTER_DRAIN) { E(acc, cur, wr, wc, fr, fq); S.done(cur); }
        if (!has_next) break;
#pragma unroll
        for (int a = 0; a < 2; ++a)
#pragma unroll
            for (int b = 0; b < 2; ++b)
#pragma unroll
                for (int m = 0; m < 4; ++m)
#pragma unroll
                    for (int n = 0; n < 2; ++n) acc[a][b][m][n] = (f32x4){0.f, 0.f, 0.f, 0.f};
        cur = nxt; cA = nA; cB = nB; ++ui;
        if constexpr (ALIGN_EPI) { if (wr == 1) PG8_BAR; }
    }
    PG8_WAIT_V(0);
    if constexpr (!ALIGN_EPI) { if (wr == 0) PG8_BAR; }
    PG8_BAR;
    if constexpr (Epi::AFTER_DRAIN) { E.fused(acc, cur, wr, wc, fr, fq, lds, wid, lane); S.done(cur); }
#undef PG8_SA
#undef PG8_SB
#undef PG8_STAGE
#undef PG8_LDA
#undef PG8_LDB
#undef PG8_MMA
#undef PG8_WAIT_V
#undef PG8_WAIT_L
#undef PG8_BAR
#undef PG8_SCHED
}
}
#include <hip/hip_bf16.h>
#include <cmath>
namespace attn_body {
using bf16=__hip_bfloat16;
using bf16x8=__attribute__((ext_vector_type(8)))short;
using s16x4=__attribute__((ext_vector_type(4)))short;
using f32x16=__attribute__((ext_vector_type(16)))float;
using u32x4=__attribute__((ext_vector_type(4)))unsigned;
constexpr int BATCH=2,NHEAD=16,SEQ=8192,D=64,DM=1536,OP=1024;
constexpr int NW=8,QBLK=32,QB=QBLK*NW,KVBLK=64,NQB=SEQ/QB;
constexpr int ATTN_PITCH=DM, ATTN_UNIT_ROWS=QB;
__device__ __forceinline__ int crow(int r,int hi){return (r&3)+8*(r>>2)+4*hi;}
#define SBAR() __builtin_amdgcn_sched_barrier(0)
__device__ __forceinline__ void cmask(f32x16&p0,f32x16&p1,int jb,int qrel,int hi){
  const float NEG=-INFINITY; int kb=64*jb+4*hi; const int ql=qrel|63;
  #pragma unroll
  for(int r=0;r<16;++r){int kv=kb+(r&3)+8*(r>>2); if(kv>ql)p0[r]=NEG; if(kv+32>ql)p1[r]=NEG;}
}

constexpr int NSLOT=3, SLOTB=8192;
constexpr int LDS_K=0, LDS_V=NSLOT*SLOTB, LDS_WS=2*NSLOT*SLOTB, LDS_OST=LDS_WS+NW*64*4, LDS_BYTES=LDS_OST+NW*4096;
constexpr float C2=0.125f*1.4426950408889634f;
__device__ __forceinline__ void glds16(const void*gsrc,unsigned lds_dst){unsigned keep;
  asm volatile("s_mov_b32 %0, m0\n\ts_mov_b32 m0, %2\n\ts_nop 0\n\tglobal_load_lds_dwordx4 %1, off\n\ts_mov_b32 m0, %0":"=&s"(keep):"v"(gsrc),"s"(lds_dst):"memory");}
__device__ __forceinline__ float max3f(float a,float b,float c){float r;asm("v_max3_f32 %0, %1, %2, %3":"=v"(r):"v"(a),"v"(b),"v"(c));return r;}
__device__ __forceinline__ float max2f(float a,float b){float r;asm("v_max_f32_e32 %0, %1, %2":"=v"(r):"v"(a),"v"(b));return r;}
__device__ __forceinline__ float fadd_s(float a,float b){float r;asm("v_add_f32_e32 %0, %1, %2":"=v"(r):"v"(a),"v"(b));return r;}
__device__ __forceinline__ float fsub_s(float a,float b){float r;asm("v_sub_f32_e32 %0, %1, %2":"=v"(r):"v"(a),"v"(b));return r;}
typedef float f32x2_t __attribute__((ext_vector_type(2))); typedef __bf16 bf16x2_t __attribute__((ext_vector_type(2)));
__device__ __forceinline__ unsigned cvtpk_s(float lo,float hi){f32x2_t v={lo,hi};bf16x2_t b=__builtin_convertvector(v,bf16x2_t);return __builtin_bit_cast(unsigned,b);}
#define WAIT_BAR(N) asm volatile("s_waitcnt vmcnt(" #N ") lgkmcnt(0)\n\ts_barrier":::"memory")

__device__ __forceinline__ void qkt(f32x16&p0,f32x16&p1,const char*Kslot,const bf16x8*qr,const f32x16&negm,int r32,int hi){
  const char*kb=Kslot+hi*1024+r32*16;
  #pragma unroll
  for(int d0=0;d0<4;++d0){
    const bf16x8 b0=*reinterpret_cast<const bf16x8*>(kb+d0*2048);
    const bf16x8 b1=*reinterpret_cast<const bf16x8*>(kb+d0*2048+512);
    if(d0==0){p0=__builtin_amdgcn_mfma_f32_32x32x16_bf16(b0,qr[0],negm,0,0,0);p1=__builtin_amdgcn_mfma_f32_32x32x16_bf16(b1,qr[0],negm,0,0,0);}
    else{p0=__builtin_amdgcn_mfma_f32_32x32x16_bf16(b0,qr[d0],p0,0,0,0);p1=__builtin_amdgcn_mfma_f32_32x32x16_bf16(b1,qr[d0],p1,0,0,0);}}
}
typedef __attribute__((address_space(3))) const char* lds_cptr;
typedef short v4i16_t __attribute__((ext_vector_type(4)));
__device__ __forceinline__ void kload8(bf16x8*kf,lds_cptr kp){
  kf[0]=*(const __attribute__((address_space(3))) bf16x8*)(kp);      kf[1]=*(const __attribute__((address_space(3))) bf16x8*)(kp+512);
  kf[2]=*(const __attribute__((address_space(3))) bf16x8*)(kp+2048); kf[3]=*(const __attribute__((address_space(3))) bf16x8*)(kp+2560);
  kf[4]=*(const __attribute__((address_space(3))) bf16x8*)(kp+4096); kf[5]=*(const __attribute__((address_space(3))) bf16x8*)(kp+4608);
  kf[6]=*(const __attribute__((address_space(3))) bf16x8*)(kp+6144); kf[7]=*(const __attribute__((address_space(3))) bf16x8*)(kp+6656);
}
__device__ __forceinline__ void kload2(bf16x8*kf,lds_cptr kp,int j){ kf[2*j]=*(const __attribute__((address_space(3))) bf16x8*)(kp+j*2048); kf[2*j+1]=*(const __attribute__((address_space(3))) bf16x8*)(kp+j*2048+512); }
__device__ __forceinline__ s16x4 vtr(lds_cptr p){ return __builtin_bit_cast(s16x4,__builtin_amdgcn_ds_read_tr16_b64_v4i16((__attribute__((address_space(3))) v4i16_t*)p)); }
__device__ __forceinline__ float rowmax(const f32x16&p0,const f32x16&p1){
  float a=max3f(p0[0],p0[1],p1[0]),b=max3f(p0[2],p0[3],p1[1]);a=max3f(a,p1[2],p1[3]);
  #pragma unroll
  for(int r=4;r<16;r+=4){a=max3f(a,p0[r],p0[r+1]);b=max3f(b,p0[r+2],p0[r+3]);a=max3f(a,p1[r],p1[r+1]);b=max3f(b,p1[r+2],p1[r+3]);}
  const float m=max2f(a,b);
  auto rr=__builtin_amdgcn_permlane32_swap(__float_as_uint(m),__float_as_uint(m),false,false);
  return max2f(__uint_as_float(rr[0]),__uint_as_float(rr[1]));
}
__device__ __forceinline__ void pv(f32x16*o,int vb,bf16x8 pa0,bf16x8 pa1,bf16x8 pa2,bf16x8 pa3){
  #pragma unroll
  for(int d0=0;d0<2;++d0){s16x4 lo[4],hi[4];
    #pragma unroll
    for(int ks=0;ks<4;++ks){
      asm volatile("ds_read_b64_tr_b16 %0,%1 offset:%c2":"=&v"(lo[ks]):"v"(vb),"i"(d0*4096+ks*1024):"memory");
      asm volatile("ds_read_b64_tr_b16 %0,%1 offset:%c2":"=&v"(hi[ks]):"v"(vb),"i"(d0*4096+ks*1024+512):"memory");}
    asm volatile("s_waitcnt lgkmcnt(0)":::"memory");SBAR();
    #define PK(k) (bf16x8){lo[k][0],lo[k][1],lo[k][2],lo[k][3],hi[k][0],hi[k][1],hi[k][2],hi[k][3]}
    o[d0]=__builtin_amdgcn_mfma_f32_32x32x16_bf16(pa0,PK(0),o[d0],0,0,0);
    o[d0]=__builtin_amdgcn_mfma_f32_32x32x16_bf16(pa1,PK(1),o[d0],0,0,0);
    o[d0]=__builtin_amdgcn_mfma_f32_32x32x16_bf16(pa2,PK(2),o[d0],0,0,0);
    o[d0]=__builtin_amdgcn_mfma_f32_32x32x16_bf16(pa3,PK(3),o[d0],0,0,0);
    #undef PK
  }
}

#ifndef ATTN_STORE16
#define ATTN_STORE16(p,v) (*(u32x4*)(p)=(v))
#endif
template<int THRL> __device__ __forceinline__ void attn_unit(int b,int qb,const bf16*Q,const bf16*__restrict__ K,const bf16*__restrict__ V,bf16*O,char*shm){
  int tid_=threadIdx.x; asm volatile("":"+v"(tid_));
  const int tid=tid_,lane=tid&63,r32=lane&31,hi=lane>>5; const int wid=__builtin_amdgcn_readfirstlane(tid>>6);
  const long rowbase=(long)b*SEQ; const int q0=qb*QB;
  const bf16*Qw=Q+(rowbase+q0+wid*QBLK)*DM;
  const bf16*Kh=K+rowbase*DM,*Vh=V+rowbase*DM;
  const unsigned lds0=(unsigned)(uintptr_t)shm;
  float*wsf=(float*)(shm+LDS_WS)+wid*64;
  const bf16*ksrc=Kh+(long)lane*DM+wid*8;
  const bf16*vsrc=Vh+(long)(16*(wid&3)+(lane>>2))*DM+(wid>>2)*32+(lane&3)*8;
  const unsigned kdst=lds0+LDS_K+wid*1024, vdst=lds0+LDS_V+wid*1024;
  #define DMA_K(t,slot) glds16(ksrc+(long)(t)*KVBLK*DM,(unsigned)__builtin_amdgcn_readfirstlane(kdst+(slot)))
  #define DMA_V(t,slot) glds16(vsrc+(long)(t)*KVBLK*DM,(unsigned)__builtin_amdgcn_readfirstlane(vdst+(slot)))
  const int vb0=(int)(lds0+LDS_V)+((lane>>4)&1)*32+(lane&3)*8+(4*hi+((lane&15)>>2))*64;
  const char*Kbase=shm+LDS_K; bf16x8 kf[8];
  const lds_cptr shm3=(lds_cptr)shm; const lds_cptr kp0=shm3+LDS_K+hi*1024+r32*16; const lds_cptr vp0=shm3+LDS_V+((lane>>4)&1)*32+(lane&3)*8+(4*hi+((lane&15)>>2))*64;
  const int NT=(q0+QB)/KVBLK;
  DMA_K(0,0);DMA_V(0,0);DMA_K(1,SLOTB);
  bf16x8 qr[4];
  #pragma unroll
  for(int d0=0;d0<4;++d0)qr[d0]=*reinterpret_cast<const bf16x8*>(&Qw[(long)r32*DM+d0*16+hi*8]);
  float mhat=0.f,l_reg=0.f;f32x16 o[2];o[0]=f32x16{};o[1]=f32x16{};f32x16 negm=f32x16{};asm volatile("":"+v"(negm));
  const int qrel=wid*QBLK+r32;
  #define CMASK(P0,P1,t) do{int jb_=(t)-(NT-4); if(jb_>=0)cmask(P0,P1,jb_,qrel,hi);}while(0)
  bool resc=false;
  #define START(P0,P1) do{ const float rm=rowmax(P0,P1); resc=false; \
    { const float dl=rm; mhat=fadd_s(mhat,dl); \
      _Pragma("unroll") for(int r=0;r<16;++r){P0[r]=fsub_s(P0[r],dl);P1[r]=fsub_s(P1[r],dl);} \
      _Pragma("unroll") for(int r=0;r<16;++r)negm[r]=-mhat; asm volatile("":"+v"(negm)); } \
    _Pragma("unroll") for(int r=0;r<16;++r)P0[r]=__builtin_amdgcn_exp2f(P0[r]); }while(0)
  #define RESC() do{ if(resc){ asm volatile("s_waitcnt lgkmcnt(0)":::"memory"); \
      _Pragma("unroll") for(int d_=0;d_<2;++d_) _Pragma("unroll") for(int r=0;r<16;++r)o[d_][r]*=wsf[crow(r,hi)]; } }while(0)
  f32x16 pA0,pA1,pB0,pB1;
  int sl_prev=0,sl_cur=0,sl_next=SLOTB;
  #define ROT() do{sl_prev=sl_cur;sl_cur=sl_next;sl_next=(sl_next==(NSLOT-1)*SLOTB)?0:sl_next+SLOTB;}while(0)
  DMA_K(2,2*SLOTB);
  WAIT_BAR(3);
  qkt(pA0,pA1,Kbase,qr,negm,r32,hi);asm volatile("s_nop 15\n\ts_nop 7":"+v"(pA0),"+v"(pA1));CMASK(pA0,pA1,0);
  START(pA0,pA1);
  _Pragma("unroll") for(int r=0;r<16;++r)pA1[r]=__builtin_amdgcn_exp2f(pA1[r]);
  WAIT_BAR(0);
  DMA_K(3,0);DMA_V(1,SLOTB);
  ROT();
  kload8(kf,kp0+sl_cur);
  WAIT_BAR(2);
  s16x4 vlo[8],vhi[8]; u32x4 pw0,pw1,pw2,pw3;
  #define PKW(P,B) cvtpk_s(P[B],P[B+1])
  #define PAF(k) __builtin_bit_cast(bf16x8,pw##k)
  #define VFR(i) (bf16x8){vlo[i][0],vlo[i][1],vlo[i][2],vlo[i][3],vhi[i][0],vhi[i][1],vhi[i][2],vhi[i][3]}
  #define PIN(x) asm volatile("":"+v"(x))
  #define MX3(a,b,c) __builtin_fmaxf(__builtin_fmaxf((a),(b)),(c))
  #define GAPA(MF,A0,A1,A2,A3,W0,W1,PW) do{ MF; sacc+=A0; sacc+=A1; sacc+=A2; sacc+=A3; PIN(sacc); W0; W1; PIN(PW); SBAR(); }while(0)
  #define EX(v) __builtin_amdgcn_exp2f(v)
  #define GAPB(MF,X,B) do{ MF; X[B]=EX(X[B]); X[B+1]=EX(X[B+1]); X[B+2]=EX(X[B+2]); X[B+3]=EX(X[B+3]); PIN(X); SBAR(); }while(0)
  #define VRD(i) do{ vlo[i]=vtr(vp_+(((i)>>2)*4096+((i)&3)*1024)); vhi[i]=vtr(vp_+(((i)>>2)*4096+((i)&3)*1024+512)); }while(0)
  #define KRD(G,j) do{ if(G){ kload2(kf,kp0+sl_next,j); SBAR(); } }while(0)
  #define STEP(C0,C1,P0,P1,t,GK,GV,GL) do{ SBAR(); \
    const lds_cptr vp_=vp0+sl_prev; \
    VRD(0); SBAR(); float sacc=(P0[0]+P0[1]); \
    GAPA(C0=__builtin_amdgcn_mfma_f32_32x32x16_bf16(kf[0],qr[0],negm,0,0,0), P0[2],P0[3],P0[4],P0[5],     pw0[0]=PKW(P0,0), pw0[1]=PKW(P0,2), pw0); \
    VRD(4); SBAR(); GAPA(C1=__builtin_amdgcn_mfma_f32_32x32x16_bf16(kf[1],qr[0],negm,0,0,0), P0[6],P0[7],P0[8],P0[9],     pw0[2]=PKW(P0,4), pw0[3]=PKW(P0,6), pw0); \
    VRD(1); SBAR(); GAPA(C0=__builtin_amdgcn_mfma_f32_32x32x16_bf16(kf[2],qr[1],C0,0,0,0),   P0[10],P0[11],P0[12],P0[13], pw1[0]=PKW(P0,8), pw1[1]=PKW(P0,10), pw1); \
    VRD(5); SBAR(); GAPA(C1=__builtin_amdgcn_mfma_f32_32x32x16_bf16(kf[3],qr[1],C1,0,0,0),   P0[14],P0[15],P1[0],P1[1],   pw1[2]=PKW(P0,12),pw1[3]=PKW(P0,14), pw1); \
    VRD(2); SBAR(); GAPA(C0=__builtin_amdgcn_mfma_f32_32x32x16_bf16(kf[4],qr[2],C0,0,0,0),   P1[2],P1[3],P1[4],P1[5],     pw2[0]=PKW(P1,0), pw2[1]=PKW(P1,2), pw2); \
    VRD(6); SBAR(); GAPA(C1=__builtin_amdgcn_mfma_f32_32x32x16_bf16(kf[5],qr[2],C1,0,0,0),   P1[6],P1[7],P1[8],P1[9],     pw2[2]=PKW(P1,4), pw2[3]=PKW(P1,6), pw2); \
    VRD(3); SBAR(); GAPA(C0=__builtin_amdgcn_mfma_f32_32x32x16_bf16(kf[6],qr[3],C0,0,0,0),   P1[10],P1[11],P1[12],P1[13], pw3[0]=PKW(P1,8), pw3[1]=PKW(P1,10), pw3); \
    VRD(7); SBAR(); GAPA(C1=__builtin_amdgcn_mfma_f32_32x32x16_bf16(kf[7],qr[3],C1,0,0,0),   P1[14],P1[15],0.f,0.f,       pw3[2]=PKW(P1,12),pw3[3]=PKW(P1,14), pw3); \
    l_reg+=sacc; \
    if(GK){DMA_K((t)+3,sl_cur);} if(GV){DMA_V((t)+1,sl_next);} \
    CMASK(C0,C1,t); \
    { float a=MX3(C0[0],C0[1],C1[0]),b=MX3(C0[2],C0[3],C1[1]); a=MX3(a,C1[2],C1[3]); \
      _Pragma("unroll") for(int r=4;r<16;r+=4){a=MX3(a,C0[r],C0[r+1]);b=MX3(b,C0[r+2],C0[r+3]);a=MX3(a,C1[r],C1[r+1]);b=MX3(b,C1[r+2],C1[r+3]);} \
      float rm=__builtin_fmaxf(a,b); { auto rr=__builtin_amdgcn_permlane32_swap(__float_as_uint(rm),__float_as_uint(rm),false,false); rm=__builtin_fmaxf(__uint_as_float(rr[0]),__uint_as_float(rr[1])); } \
      resc=false; \
      if(__builtin_expect(__any(rm>(float)THRL),0)){ const float dl=__builtin_fmaxf(rm,0.f); mhat+=dl; \
        _Pragma("unroll") for(int r=0;r<16;++r){C0[r]-=dl;C1[r]-=dl;} \
        _Pragma("unroll") for(int r=0;r<16;++r)negm[r]=-mhat; asm volatile("":"+v"(negm)); \
        const float f=__builtin_amdgcn_exp2f(-dl); l_reg*=f; if(hi==0)wsf[r32]=f; resc=true; } } \
    SBAR(); \
    GAPB(o[0]=__builtin_amdgcn_mfma_f32_32x32x16_bf16(PAF(0),VFR(0),o[0],0,0,0), C0,0); \
    GAPB(o[1]=__builtin_amdgcn_mfma_f32_32x32x16_bf16(PAF(0),VFR(4),o[1],0,0,0), C0,4); \
    KRD(GL,0); GAPB(o[0]=__builtin_amdgcn_mfma_f32_32x32x16_bf16(PAF(1),VFR(1),o[0],0,0,0), C0,8); \
    KRD(GL,1); GAPB(o[1]=__builtin_amdgcn_mfma_f32_32x32x16_bf16(PAF(1),VFR(5),o[1],0,0,0), C0,12); \
    KRD(GL,2); GAPB(o[0]=__builtin_amdgcn_mfma_f32_32x32x16_bf16(PAF(2),VFR(2),o[0],0,0,0), C1,0); \
    KRD(GL,3); GAPB(o[1]=__builtin_amdgcn_mfma_f32_32x32x16_bf16(PAF(2),VFR(6),o[1],0,0,0), C1,4); \
    GAPB(o[0]=__builtin_amdgcn_mfma_f32_32x32x16_bf16(PAF(3),VFR(3),o[0],0,0,0), C1,8); \
    GAPB(o[1]=__builtin_amdgcn_mfma_f32_32x32x16_bf16(PAF(3),VFR(7),o[1],0,0,0), C1,12); \
    }while(0)
  int t=1;
  #undef CMASK
  #define CMASK(P0,P1,t) do{}while(0)
  for(;t+5<NT;t+=2){
    STEP(pB0,pB1,pA0,pA1,t,true,true,true);     WAIT_BAR(2); RESC(); ROT();
    STEP(pA0,pA1,pB0,pB1,t+1,true,true,true);   WAIT_BAR(2); RESC(); ROT();
  }
  #undef CMASK
  #define CMASK(P0,P1,t) do{int jb_=(t)-(NT-4); if(jb_>=0)cmask(P0,P1,jb_,qrel,hi);}while(0)
  #define ENDW(tt) do{ if((tt)+3<NT){WAIT_BAR(2);} else if((tt)+2<NT){WAIT_BAR(1);} else {WAIT_BAR(0);} }while(0)
  for(;t+1<NT;t+=2){
    STEP(pB0,pB1,pA0,pA1,t,(t+3<NT),(t+1<NT),(t+1<NT));       ENDW(t);   RESC(); ROT();
    STEP(pA0,pA1,pB0,pB1,t+1,(t+4<NT),(t+2<NT),(t+2<NT));     ENDW(t+1); RESC(); ROT();
  }
  STEP(pB0,pB1,pA0,pA1,NT-1,false,false,false); RESC();
  { float sacc=pB0[0]+pB0[1]; _Pragma("unroll") for(int r=2;r<16;++r)sacc+=pB0[r]; _Pragma("unroll") for(int r=0;r<16;++r)sacc+=pB1[r]; l_reg+=sacc;
    pw0=(u32x4){PKW(pB0,0),PKW(pB0,2),PKW(pB0,4),PKW(pB0,6)};pw1=(u32x4){PKW(pB0,8),PKW(pB0,10),PKW(pB0,12),PKW(pB0,14)};pw2=(u32x4){PKW(pB1,0),PKW(pB1,2),PKW(pB1,4),PKW(pB1,6)};pw3=(u32x4){PKW(pB1,8),PKW(pB1,10),PKW(pB1,12),PKW(pB1,14)};
    SBAR(); pv(o,vb0+sl_cur,PAF(0),PAF(1),PAF(2),PAF(3)); }
  #undef PKW
  #undef PAF
  #undef VFR
  #undef PIN
  #undef MX3
  #undef GAPA
  #undef GAPB
  #undef EX
  #undef VRD
  #undef KRD
  #undef STEP
  #undef ENDW
  {auto rr=__builtin_amdgcn_permlane32_swap(__float_as_uint(l_reg),__float_as_uint(l_reg),false,false);l_reg=__uint_as_float(rr[0])+__uint_as_float(rr[1]);}
  if(hi==0)wsf[32+r32]=l_reg;asm volatile("s_waitcnt lgkmcnt(0)":::"memory");
  float rli[16];
  #pragma unroll
  for(int r=0;r<16;++r)rli[r]=__builtin_amdgcn_rcpf(wsf[32+crow(r,hi)]);
  bf16*Ow=O+(rowbase+q0+wid*QBLK)*OP;
  { bf16*stg=(bf16*)(shm+LDS_OST)+wid*2048;
    #pragma unroll
    for(int r=0;r<16;++r){const int orow=crow(r,hi);
      #pragma unroll
      for(int d0=0;d0<2;++d0)stg[orow*64+d0*32+r32]=__float2bfloat16(o[d0][r]*rli[r]);}
    asm volatile("s_waitcnt lgkmcnt(0)":::"memory");
    #pragma unroll
    for(int i=0;i<4;++i){const int row=i*8+(lane>>3),ch=lane&7; const u32x4 v=*(const u32x4*)(stg+row*64+ch*8); ATTN_STORE16(Ow+(long)row*OP+ch*8,v);} }
  asm volatile("s_waitcnt lgkmcnt(0)\n\ts_barrier":::"memory");
  #undef DMA_K
  #undef DMA_V
  #undef CMASK
  #undef START
  #undef RESC
  #undef ROT
}
constexpr int ATTN_LDS_BYTES=LDS_BYTES;
template<int THRL=8> __device__ __forceinline__ void attn_unit_vh(int b,int vh,int qb,const bf16*zda,bf16*O,char*lds){
  const int h=vh>>2,m=(vh>>1)&1,half=vh&1;
  attn_unit<THRL>(b,qb,zda+(h*2+m)*64,zda+512+(h*2+m)*64,zda+1024+h*128+half*64,O+vh*64,lds);
}
#undef SBAR
#undef WAIT_BAR
}

constexpr int BATCH = 2, SEQ = 8192, DM = 1024, M = BATCH * SEQ, FF = 4096;
constexpr int RW_IN = 1792, DA_IN = 1536, GATE_IN = 2048, IN_W = 5376;
constexpr float C2 = 0.125f * 1.4426950408889634f;
constexpr float LAMBDA_INIT = 0.2f;
constexpr size_t KiB = 1024, MiB = 1u << 20;
constexpr size_t WS_CTL = 0;
constexpr size_t WS_WIN = 256 * KiB;
constexpr size_t WS_WRW = WS_WIN + (size_t)IN_W * DM * 2;
constexpr size_t WS_WDA = WS_WRW + 1 * MiB;
constexpr size_t WS_WO = WS_WDA + 1 * MiB;
constexpr size_t WS_WUP = WS_WO + 2 * MiB;
constexpr size_t WS_WDN = WS_WUP + 8 * MiB;
constexpr size_t WS_LORA = WS_WDN + 8 * MiB;
constexpr size_t WS_XN = WS_LORA + 768 * KiB;
constexpr size_t WS_ZRW = WS_XN + 32 * MiB;
constexpr size_t WS_ZDA = WS_ZRW + 56 * MiB;
constexpr size_t WS_ZG = WS_ZDA + 48 * MiB;
constexpr size_t WS_DAO = WS_ZG + 64 * MiB;
constexpr size_t WS_MERGED = WS_ZRW;
constexpr size_t WS_Y = WS_MERGED + 32 * MiB;
constexpr size_t WS_H = WS_ZRW;
constexpr size_t WS_F = WS_H + 128 * MiB;
constexpr size_t WS_END = WS_F + 64 * MiB;
static_assert(WS_XN == 32256 * KiB, "map");
static_assert(WS_DAO + 16 * MiB <= 256 * MiB && WS_END <= 256 * MiB, "d_ws map");
constexpr size_t DO_DEC = 0, DO_A = 16 * MiB, DO_G = 32 * MiB, DO_YRAW = 48 * MiB, DO_RWO = 0;

#define LAS __attribute__((address_space(3)))
typedef unsigned short bf16;
typedef unsigned v4u __attribute__((ext_vector_type(4)));
typedef unsigned v2u __attribute__((ext_vector_type(2)));
typedef float f32x4 __attribute__((ext_vector_type(4)));
constexpr int NWAVES = 8, NTHR = 512;
constexpr int LDS_BYTES = 147456;

__device__ __forceinline__ float bf2f(unsigned b) { return __uint_as_float(b << 16); }
__device__ __forceinline__ float bflo(unsigned w) { return __uint_as_float(w << 16); }
__device__ __forceinline__ float bfhi(unsigned w) { return __uint_as_float(w & 0xffff0000u); }
__device__ __forceinline__ unsigned f2bf(float f) { unsigned u = __float_as_uint(f); return (u + 0x7fffu + ((u >> 16) & 1u)) >> 16; }
__device__ __forceinline__ unsigned pk2(float lo, float hi) { return f2bf(lo) | (f2bf(hi) << 16); }
__device__ __forceinline__ float sigmoidf_(float x) { return 1.0f / (1.0f + __expf(-x)); }
__device__ __forceinline__ float wave_sum(float v) {
#pragma unroll
    for (int o = 1; o < 64; o <<= 1) v += __shfl_xor(v, o);
    return v;
}
__device__ __forceinline__ float wave_max(float v) {
#pragma unroll
    for (int o = 1; o < 64; o <<= 1) v = fmaxf(v, __shfl_xor(v, o));
    return v;
}

struct Args { const float* in[27]; float* out; unsigned char* ws; int ph_lo, ph_hi; };

struct EpiG1 {
    static constexpr bool PERM = true, AFTER_DRAIN = false;
    bf16 *zrw, *zda, *zg;
    __device__ __forceinline__ void operator()(const f32x4 (&acc)[2][2][4][2], const pg8::Unit& u, int wr, int wc, int fr, int fq) const {
        bf16* base; int ldc, colt; float sc = 1.f; bool sg = false;
        if (u.pn < 7) { base = zrw; ldc = RW_IN; colt = u.pn * 256; }
        else if (u.pn < 13) { base = zda; ldc = DA_IN; colt = (u.pn - 7) * 256; if (u.pn < 9) sc = C2; }
        else { base = zg; ldc = GATE_IN; colt = (u.pn - 13) * 256; sg = true; }
#pragma unroll
        for (int ai = 0; ai < 2; ++ai)
#pragma unroll
            for (int m = 0; m < 4; ++m) { const int row = u.pm * 256 + ai * 128 + wr * 64 + m * 16 + fr;
#pragma unroll
                for (int bj = 0; bj < 2; ++bj) { const int col = colt + bj * 128 + wc * 32 + 8 * fq;
                    f32x4 v0 = acc[ai][bj][m][0], v1 = acc[ai][bj][m][1];
                    if (sg) {
#pragma unroll
                        for (int e = 0; e < 4; ++e) { v0[e] = sigmoidf_(v0[e]); v1[e] = sigmoidf_(v1[e]); } }
                    else { v0 = v0 * sc; v1 = v1 * sc; }
                    v4u w; w.x = pg8::cvt_pk_bf16(v0[0], v0[1]); w.y = pg8::cvt_pk_bf16(v0[2], v0[3]); w.z = pg8::cvt_pk_bf16(v1[0], v1[1]); w.w = pg8::cvt_pk_bf16(v1[2], v1[3]);
                    *(v4u*)(base + (size_t)row * ldc + col) = w; } }
    }
};
struct EpiLora {
    static constexpr bool PERM = true, AFTER_DRAIN = false;
    bf16 *dec, *av, *gv; const float *w0, *a0;
    __device__ __forceinline__ unsigned one(float v, float bias, int kind) const {
        if (kind == 0) { const float y = -(bias + v); const float sp = fmaxf(y, 0.f) + __logf(1.0f + __expf(-fabsf(y)));
            const float d = __expf(-__expf(-sp - 0.5f)); float q = rintf((d - 0.5f) * 131070.0f); q = fminf(fmaxf(q, 0.f), 65535.f); return (unsigned)q; }
        if (kind == 1) return f2bf(1.0f / (1.0f + __expf(-(bias + v))));
        return f2bf(v);
    }
    __device__ __forceinline__ void operator()(const f32x4 (&acc)[2][2][4][2], const pg8::Unit& u, int wr, int wc, int fr, int fq) const {
        const int kind = u.pn >> 1; bf16* base = dec + (size_t)kind * ((size_t)M * 512); const int colt = (u.pn & 1) * 256;
        const float* bias = kind == 0 ? w0 : a0;
#pragma unroll
        for (int bj = 0; bj < 2; ++bj) { const int col = colt + bj * 128 + wc * 32 + 8 * fq;
            f32x4 b0 = (f32x4){0.f, 0.f, 0.f, 0.f}, b1 = b0;
            if (kind < 2) { b0 = *(const f32x4*)(bias + col); b1 = *(const f32x4*)(bias + col + 4); }
#pragma unroll
            for (int ai = 0; ai < 2; ++ai)
#pragma unroll
                for (int m = 0; m < 4; ++m) { const int row = u.pm * 256 + ai * 128 + wr * 64 + m * 16 + fr;
                    const f32x4 v0 = acc[ai][bj][m][0], v1 = acc[ai][bj][m][1];
                    v4u w;
                    w.x = one(v0[0], b0[0], kind) | (one(v0[1], b0[1], kind) << 16); w.y = one(v0[2], b0[2], kind) | (one(v0[3], b0[3], kind) << 16);
                    w.z = one(v1[0], b1[0], kind) | (one(v1[1], b1[1], kind) << 16); w.w = one(v1[2], b1[2], kind) | (one(v1[3], b1[3], kind) << 16);
                    *(v4u*)(base + (size_t)row * 512 + col) = w; asm volatile("" ::: "memory"); } }
    }
};
template <int MODE> struct EpiGate {
    static constexpr bool PERM = true, AFTER_DRAIN = false;
    const bf16* sg; int goff; float* tmp; bf16* merged;
    __device__ __forceinline__ void operator()(const f32x4 (&acc)[2][2][4][2], const pg8::Unit& u, int wr, int wc, int fr, int fq) const {
#pragma unroll
        for (int ai = 0; ai < 2; ++ai)
#pragma unroll
            for (int m = 0; m < 4; ++m) { const int row = u.pm * 256 + ai * 128 + wr * 64 + m * 16 + fr;
#pragma unroll
                for (int bj = 0; bj < 2; ++bj) { const int col = u.pn * 256 + bj * 128 + wc * 32 + 8 * fq;
                    const v4u g = *(const v4u*)(sg + (size_t)row * GATE_IN + goff + col);
                    f32x4 v0 = acc[ai][bj][m][0], v1 = acc[ai][bj][m][1];
                    v0[0] *= bflo(g.x); v0[1] *= bfhi(g.x); v0[2] *= bflo(g.y); v0[3] *= bfhi(g.y);
                    v1[0] *= bflo(g.z); v1[1] *= bfhi(g.z); v1[2] *= bflo(g.w); v1[3] *= bfhi(g.w);
                    float* tp = tmp + (size_t)row * DM + col;
                    if (MODE == 0) { *(f32x4*)tp = v0; *(f32x4*)(tp + 4) = v1; }
                    else { v0 += *(const f32x4*)tp; v1 += *(const f32x4*)(tp + 4);
                        v4u w; w.x = pg8::cvt_pk_bf16(v0[0], v0[1]); w.y = pg8::cvt_pk_bf16(v0[2], v0[3]); w.z = pg8::cvt_pk_bf16(v1[0], v1[1]); w.w = pg8::cvt_pk_bf16(v1[2], v1[3]);
                        *(v4u*)(merged + (size_t)row * DM + col) = w; }
                    asm volatile("" ::: "memory"); } }
    }
};
struct EpiF32 {
    static constexpr bool PERM = true, AFTER_DRAIN = false;
    float* out; int ldc;
    __device__ __forceinline__ void operator()(const f32x4 (&acc)[2][2][4][2], const pg8::Unit& u, int wr, int wc, int fr, int fq) const {
#pragma unroll
        for (int ai = 0; ai < 2; ++ai)
#pragma unroll
            for (int m = 0; m < 4; ++m) { const int row = u.pm * 256 + ai * 128 + wr * 64 + m * 16 + fr;
#pragma unroll
                for (int bj = 0; bj < 2; ++bj) { const int col = u.pn * 256 + bj * 128 + wc * 32 + 8 * fq;
                    float* p = out + (size_t)row * ldc + col; *(f32x4*)p = acc[ai][bj][m][0]; *(f32x4*)(p + 4) = acc[ai][bj][m][1]; } }
    }
};
struct EpiRelu2 {
    static constexpr bool PERM = true, AFTER_DRAIN = false;
    bf16* out; int ldc;
    __device__ __forceinline__ void operator()(const f32x4 (&acc)[2][2][4][2], const pg8::Unit& u, int wr, int wc, int fr, int fq) const {
#pragma unroll
        for (int ai = 0; ai < 2; ++ai)
#pragma unroll
            for (int m = 0; m < 4; ++m) { const int row = u.pm * 256 + ai * 128 + wr * 64 + m * 16 + fr;
#pragma unroll
                for (int bj = 0; bj < 2; ++bj) { const int col = u.pn * 256 + bj * 128 + wc * 32 + 8 * fq;
                    f32x4 v0 = acc[ai][bj][m][0], v1 = acc[ai][bj][m][1];
#pragma unroll
                    for (int e = 0; e < 4; ++e) { const float a0 = fmaxf(v0[e], 0.f), a1 = fmaxf(v1[e], 0.f); v0[e] = a0 * a0; v1[e] = a1 * a1; }
                    v4u w; w.x = pg8::cvt_pk_bf16(v0[0], v0[1]); w.y = pg8::cvt_pk_bf16(v0[2], v0[3]); w.z = pg8::cvt_pk_bf16(v1[0], v1[1]); w.w = pg8::cvt_pk_bf16(v1[2], v1[3]);
                    *(v4u*)(out + (size_t)row * ldc + col) = w; } }
    }
};

__device__ __forceinline__ void p0_transpose_item(const float* W, int N, bf16* WT, int ldt, LAS float* scr, int item, int lane) {
    const int nblk = N / 32, kb = item / nblk, nb = item % nblk, k0 = 64 * kb, n0 = 32 * nb;
#pragma unroll 8
    for (int i = 0; i < 32; ++i) { const int kk = 2 * i + (lane >> 5); scr[kk * 33 + (lane & 31)] = W[(size_t)(k0 + kk) * N + n0 + (lane & 31)]; }
    asm volatile("s_waitcnt lgkmcnt(0)" ::: "memory");
    const int c = lane & 7;
#pragma unroll
    for (int j = 0; j < 4; ++j) { const int n = (lane >> 3) + 8 * j; const LAS float* s = scr + (8 * c) * 33 + n;
        v4u o; o.x = pk2(s[0 * 33], s[1 * 33]); o.y = pk2(s[2 * 33], s[3 * 33]); o.z = pk2(s[4 * 33], s[5 * 33]); o.w = pk2(s[6 * 33], s[7 * 33]);
        *(v4u*)(WT + (size_t)(n0 + n) * ldt + k0 + 8 * c) = o; }
    asm volatile("s_waitcnt lgkmcnt(0)" ::: "memory");
}
__device__ __forceinline__ void p0_prologue(const Args& a, LAS unsigned char* lds) {
    int tid_ = threadIdx.x; asm volatile("" : "+v"(tid_)); const int tid = tid_, lane = tid & 63, wave = tid >> 6;
    LAS float* scr = (LAS float*)(lds + wave * 16384);
    const int gw = blockIdx.x * NWAVES + wave, NGW = gridDim.x * NWAVES;
    unsigned char* ws = a.ws;
    constexpr int I_IN = (DM / 64) * (IN_W / 32), I_RW = (512 / 64) * (DM / 32), I_O = (DM / 64) * (DM / 32), I_UP = (DM / 64) * (FF / 32), I_DN = (FF / 64) * (DM / 32);
    constexpr int I_L2 = 512 / 32, I_G2 = 2 * (512 / 32);
    constexpr int NITEMS = I_IN + 2 * I_RW + I_O + I_UP + I_DN + 2 * I_L2 + I_G2;
    for (int it = gw; it < NITEMS; it += NGW) {
        int r = it;
        if (r < I_IN) { p0_transpose_item(a.in[2], IN_W, (bf16*)(ws + WS_WIN), DM, scr, r, lane); continue; } r -= I_IN;
        if (r < I_RW) { p0_transpose_item(a.in[14], DM, (bf16*)(ws + WS_WRW), 512, scr, r, lane); continue; } r -= I_RW;
        if (r < I_RW) { p0_transpose_item(a.in[20], DM, (bf16*)(ws + WS_WDA), 512, scr, r, lane); continue; } r -= I_RW;
        if (r < I_O) { p0_transpose_item(a.in[21], DM, (bf16*)(ws + WS_WO), DM, scr, r, lane); continue; } r -= I_O;
        if (r < I_UP) { p0_transpose_item(a.in[24], FF, (bf16*)(ws + WS_WUP), DM, scr, r, lane); continue; } r -= I_UP;
        if (r < I_DN) { p0_transpose_item(a.in[25], DM, (bf16*)(ws + WS_WDN), FF, scr, r, lane); continue; } r -= I_DN;
        if (r < I_L2) { p0_transpose_item(a.in[5], 512, (bf16*)(ws + WS_LORA), 256, scr, r, lane); continue; } r -= I_L2;
        if (r < I_L2) { p0_transpose_item(a.in[7], 512, (bf16*)(ws + WS_LORA) + 512 * 256 + 64, 256, scr, r, lane); continue; } r -= I_L2;
        p0_transpose_item(a.in[8], 512, (bf16*)(ws + WS_LORA) + 1024 * 256 + 128, 256, scr, r, lane);
    }
    for (int ch = blockIdx.x * NTHR + tid; ch < 1536 * 32; ch += gridDim.x * NTHR) {
        const int n = ch >> 5, k0 = (ch & 31) * 8; const int kind = n >> 9;
        const bool nz = (kind == 0) ? (k0 < 64) : (kind == 1 ? (k0 >= 64 && k0 < 128) : (k0 >= 128));
        if (!nz) *(v4u*)((bf16*)(ws + WS_LORA) + (size_t)n * 256 + k0) = (v4u){0u, 0u, 0u, 0u};
    }
    const float* g = a.in[1];
    f32x4 gv[4];
#pragma unroll
    for (int j = 0; j < 4; ++j) gv[j] = *(const f32x4*)(g + 4 * lane + 256 * j);
    for (int m = gw; m < M; m += NGW) {
        const f32x4* xr = (const f32x4*)(a.in[0] + (size_t)m * DM) + lane;
        f32x4 v[4]; float s = 0.f;
#pragma unroll
        for (int j = 0; j < 4; ++j) { v[j] = xr[64 * j]; s += (v[j].x * v[j].x + v[j].y * v[j].y) + (v[j].z * v[j].z + v[j].w * v[j].w); }
        const float rs = 1.0f / sqrtf(wave_sum(s) * (1.f / DM) + 1e-6f);
        v2u* o8 = (v2u*)((bf16*)(ws + WS_XN) + (size_t)m * DM) + lane;
#pragma unroll
        for (int j = 0; j < 4; ++j) { v2u w; w.x = pk2(v[j].x * rs * gv[j].x, v[j].y * rs * gv[j].y); w.y = pk2(v[j].z * rs * gv[j].z, v[j].w * rs * gv[j].w); o8[64 * j] = w; }
    }
}

__device__ __forceinline__ void prep_a(const Args& a) {
    int tid_ = threadIdx.x; asm volatile("" : "+v"(tid_)); const int tid = tid_, lane = tid & 63, wave = tid >> 6;
    const int gw = blockIdx.x * NWAVES + wave, NGW = gridDim.x * NWAVES;
    const bf16* zrw = (const bf16*)(a.ws + WS_ZRW); bf16* T = (bf16*)(a.ws + WS_XN);
    const int c = 4 * lane; const f32x4 mu = *(const f32x4*)(a.in[3] + 1536 + c);
    for (int t = gw; t < M; t += NGW) {
        const v2u cur = *(const v2u*)(zrw + (size_t)t * RW_IN + 1536 + c);
        v2u prv = (v2u){0u, 0u}; if ((t & (SEQ - 1)) != 0) prv = *(const v2u*)(zrw + (size_t)(t - 1) * RW_IN + 1536 + c);
        float u[4]; const float zc[4] = {bflo(cur.x), bfhi(cur.x), bflo(cur.y), bfhi(cur.y)}, zp[4] = {bflo(prv.x), bfhi(prv.x), bflo(prv.y), bfhi(prv.y)};
#pragma unroll
        for (int e = 0; e < 4; ++e) { const float x = zc[e] + (zp[e] - zc[e]) * mu[e];
            u[e] = (c < 64) ? tanhf(x) : ((c < 128) ? x : 1.0f / (1.0f + expf(-x))); }
        v2u w; w.x = pk2(u[0], u[1]); w.y = pk2(u[2], u[3]);
        *(v2u*)(T + (size_t)t * 256 + c) = w;
    }
}

__device__ __forceinline__ float lerp_col(const bf16* zrw, int t, int col, float mu) {
    const float zc = bf2f(zrw[(size_t)t * RW_IN + col]);
    const float zp = ((t & (SEQ - 1)) != 0) ? bf2f(zrw[(size_t)(t - 1) * RW_IN + col]) : 0.f;
    return zc + (zp - zc) * mu;
}

__device__ __forceinline__ void scan_naive(const Args& a, LAS unsigned char* lds) {
    int tid_ = threadIdx.x; asm volatile("" : "+v"(tid_)); const int tid = tid_, lane = tid & 63, h = tid >> 6; const int b = blockIdx.x;
    const bf16* zrw = (const bf16*)(a.ws + WS_ZRW);
    const bf16* DEC = (const bf16*)((unsigned char*)a.out + DO_DEC); const bf16* AV = (const bf16*)((unsigned char*)a.out + DO_A);
    bf16* YR = (bf16*)((unsigned char*)a.out + DO_YRAW);
    LAS float* L = (LAS float*)lds + h * 320;
    const int col = h * 64 + lane;
    const float mu_r = a.in[3][col], mu_k = a.in[3][512 + col], mu_v = a.in[3][1024 + col];
    const float kkc = a.in[9][col], kac = a.in[10][col];
    float S[64];
#pragma unroll
    for (int j = 0; j < 64; ++j) S[j] = 0.f;
    for (int tt = 0; tt < SEQ; ++tt) {
        const int t = b * SEQ + tt;
        const float r = lerp_col(zrw, t, col, mu_r), k = lerp_col(zrw, t, 512 + col, mu_k), v = lerp_col(zrw, t, 1024 + col, mu_v);
        const float dec = 0.5f + (float)DEC[(size_t)t * 512 + col] * (1.0f / 131070.0f);
        const float av = bf2f(AV[(size_t)t * 512 + col]);
        const float kkr = k * kkc; const float n2 = wave_sum(kkr * kkr); const float kk = kkr / fmaxf(sqrtf(n2), 1e-12f);
        const float kp = k * (1.0f + (av - 1.0f) * kac);
        __syncthreads();
        L[lane] = dec; L[64 + lane] = kk; L[128 + lane] = kk * av; L[192 + lane] = kp; L[256 + lane] = r;
        __syncthreads();
        float sa = 0.f;
#pragma unroll
        for (int j = 0; j < 64; j += 4) { const f32x4 q = *(const LAS f32x4*)(L + 64 + j); sa += S[j] * q[0] + S[j + 1] * q[1] + S[j + 2] * q[2] + S[j + 3] * q[3]; asm volatile("" ::: "memory"); }
        sa = -sa; float y = 0.f;
#pragma unroll
        for (int j = 0; j < 64; j += 4) { const f32x4 w = *(const LAS f32x4*)(L + j), bb = *(const LAS f32x4*)(L + 128 + j), kq = *(const LAS f32x4*)(L + 192 + j), rq = *(const LAS f32x4*)(L + 256 + j);
#pragma unroll
            for (int e = 0; e < 4; ++e) { S[j + e] = S[j + e] * w[e] + sa * bb[e] + v * kq[e]; y += S[j + e] * rq[e]; }
            asm volatile("" ::: "memory"); }
        YR[(size_t)t * 512 + col] = (bf16)f2bf(y);
    }
}

__device__ __forceinline__ float block_max(float v, LAS float* red, int tid) {
    v = wave_max(v); __syncthreads(); if ((tid & 63) == 0) red[tid >> 6] = v; __syncthreads();
    float r = red[0];
#pragma unroll
    for (int i = 1; i < 8; ++i) r = fmaxf(r, red[i]);
    return r;
}
__device__ __forceinline__ float block_sum(float v, LAS float* red, int tid) {
    v = wave_sum(v); __syncthreads(); if ((tid & 63) == 0) red[tid >> 6] = v; __syncthreads();
    float r = red[0];
#pragma unroll
    for (int i = 1; i < 8; ++i) r += red[i];
    return r;
}
__device__ __forceinline__ void attn_naive(const Args& a, LAS unsigned char* lds, int first_blk) {
    int tid_ = threadIdx.x; asm volatile("" : "+v"(tid_)); const int tid = tid_;
    LAS float* sc = (LAS float*)lds;
    LAS float* red = (LAS float*)(lds + 65536);
    LAS float* op = (LAS float*)(lds + 65536 + 256);
    const bf16* zda = (const bf16*)(a.ws + WS_ZDA); bf16* dao = (bf16*)(a.ws + WS_DAO);
    float lam; { float s1 = 0.f, s2 = 0.f;
#pragma unroll 1
        for (int i = 0; i < 64; ++i) { s1 += a.in[15][i] * a.in[16][i]; s2 += a.in[17][i] * a.in[18][i]; } lam = expf(s1) - expf(s2) + LAMBDA_INIT; }
    const int nb = gridDim.x - first_blk;
    for (int unit = blockIdx.x - first_blk; unit < BATCH * 4 * SEQ; unit += nb) {
        const int t = unit & (SEQ - 1), h = (unit >> 13) & 3, b = unit >> 15;
        const size_t rowb = (size_t)b * SEQ; const int kend = ((t >> 6) + 1) << 6;
        float lsum[2];
#pragma unroll
        for (int m = 0; m < 2; ++m) {
            LAS float* qs = (LAS float*)(lds + 65536 + 8192);
            __syncthreads();
            if (tid < 64) qs[tid] = bf2f(zda[(rowb + t) * DA_IN + (h * 2 + m) * 64 + tid]);
            __syncthreads();
            float lmax = -INFINITY;
#pragma unroll 1
            for (int key = tid; key < kend; key += NTHR) {
                const v4u* kp = (const v4u*)(zda + (rowb + key) * DA_IN + 512 + (h * 2 + m) * 64); float s = 0.f;
#pragma unroll
                for (int c = 0; c < 8; ++c) { const v4u w = kp[c]; const f32x4 qa = *(const LAS f32x4*)(qs + 8 * c), qb = *(const LAS f32x4*)(qs + 8 * c + 4);
                    s += qa[0] * bflo(w.x) + qa[1] * bfhi(w.x) + qa[2] * bflo(w.y) + qa[3] * bfhi(w.y) + qb[0] * bflo(w.z) + qb[1] * bfhi(w.z) + qb[2] * bflo(w.w) + qb[3] * bfhi(w.w); }
                sc[m * SEQ + key] = s; lmax = fmaxf(lmax, s);
            }
            const float mx = block_max(lmax, red, tid);
            float ls = 0.f;
#pragma unroll 1
            for (int key = tid; key < kend; key += NTHR) { const float p = exp2f(sc[m * SEQ + key] - mx); sc[m * SEQ + key] = p; ls += p; }
            lsum[m] = block_sum(ls, red, tid);
        }
        __syncthreads();
        const int d = tid & 127, part = tid >> 7; float o1 = 0.f, o2 = 0.f;
        const bf16* vp = zda + rowb * DA_IN + 1024 + h * 128 + d;
#pragma unroll 2
        for (int key = part; key < kend; key += 4) { const float v = bf2f(vp[(size_t)key * DA_IN]); o1 += sc[key] * v; o2 += sc[SEQ + key] * v; }
        op[(part * 2 + 0) * 128 + d] = o1; op[(part * 2 + 1) * 128 + d] = o2;
        __syncthreads();
        float o = 0.f;
        if (tid < 128) { const float O1 = (op[d] + op[256 + d] + op[512 + d] + op[768 + d]) / lsum[0], O2 = (op[128 + d] + op[384 + d] + op[640 + d] + op[896 + d]) / lsum[1]; o = O1 - lam * O2; }
        const float ss = block_sum(o * o, red, tid);
        if (tid < 128) dao[(rowb + t) * 512 + h * 128 + d] = (bf16)f2bf(o * (1.0f / sqrtf(ss * (1.0f / 128.0f) + 1e-5f)) * a.in[19][d] * (1.0f - LAMBDA_INIT));
        __syncthreads();
    }
}

typedef float f32x2 __attribute__((ext_vector_type(2)));
template <int CTRL> __device__ __forceinline__ float dppf(float x) { return __int_as_float(__builtin_amdgcn_update_dpp(0, __float_as_int(x), CTRL, 0xF, 0xF, false)); }
__device__ __forceinline__ float row16_sum(float x) { x += dppf<0xB1>(x); x += dppf<0x4E>(x); x += dppf<0x141>(x); x += dppf<0x140>(x); return x; }
constexpr int SC_TC = 32, SC_REC = 336, SC_NCH = SEQ / SC_TC;
constexpr int SCAN_BLOCKS = 64;
__device__ __forceinline__ void scan_fast(const Args& a, LAS unsigned char* lds) {
    int tid_ = threadIdx.x; asm volatile("" : "+v"(tid_)); const int tid = tid_, lane = tid & 63; const int wave = __builtin_amdgcn_readfirstlane(tid >> 6);
    const int c = blockIdx.x, b = c >> 5, h = (c >> 2) & 7, i0 = 16 * (c & 3);
    const int jl = lane & 15, ts = lane >> 4;
    const bf16* zrw = (const bf16*)(a.ws + WS_ZRW) + (size_t)b * SEQ * RW_IN;
    const bf16* DEC = (const bf16*)((unsigned char*)a.out + DO_DEC) + (size_t)b * SEQ * 512;
    const bf16* AV = (const bf16*)((unsigned char*)a.out + DO_A) + (size_t)b * SEQ * 512;
    bf16* YR = (bf16*)((unsigned char*)a.out + DO_YRAW) + (size_t)b * SEQ * 512;
    LAS float* buf = (LAS float*)lds;
    if (wave >= 4) {
        const int pw = wave - 4, cj = h * 64 + 4 * jl, cv = 1024 + h * 64 + i0 + jl;
        const f32x4 mu_r = *(const f32x4*)(a.in[3] + cj), mu_k = *(const f32x4*)(a.in[3] + 512 + cj); const float mu_v = a.in[3][cv];
        const f32x4 kkc = *(const f32x4*)(a.in[9] + cj), kac = *(const f32x4*)(a.in[10] + cj);
        v2u zr_c[2], zr_p[2], zk_c[2], zk_p[2], dd[2], aa[2]; unsigned zv_c[2], zv_p[2];
#define SC_ISSUE(ch) do { _Pragma("unroll") for (int q = 0; q < 2; ++q) { const int t = (ch) * SC_TC + 4 * (pw * 2 + q) + ts; \
            const bf16* zc = zrw + (size_t)t * RW_IN; const bf16* zp = zc - (t > 0 ? RW_IN : 0); \
            zr_c[q] = *(const v2u*)(zc + cj); zk_c[q] = *(const v2u*)(zc + 512 + cj); zv_c[q] = zc[cv]; \
            zr_p[q] = *(const v2u*)(zp + cj); zk_p[q] = *(const v2u*)(zp + 512 + cj); zv_p[q] = zp[cv]; \
            dd[q] = *(const v2u*)(DEC + (size_t)t * 512 + cj); aa[q] = *(const v2u*)(AV + (size_t)t * 512 + cj); } } while (0)
#define SC_WRITE(ch) do { _Pragma("unroll") for (int q = 0; q < 2; ++q) { const int tt = 4 * (pw * 2 + q) + ts; const bool first = ((ch) * SC_TC + tt) == 0; \
            LAS float* rec = buf + ((ch) & 1) * (SC_TC * SC_REC) + tt * SC_REC; \
            const float rc[4] = {bflo(zr_c[q].x), bfhi(zr_c[q].x), bflo(zr_c[q].y), bfhi(zr_c[q].y)}, rp[4] = {bflo(zr_p[q].x), bfhi(zr_p[q].x), bflo(zr_p[q].y), bfhi(zr_p[q].y)}; \
            const float kc[4] = {bflo(zk_c[q].x), bfhi(zk_c[q].x), bflo(zk_c[q].y), bfhi(zk_c[q].y)}, kp_[4] = {bflo(zk_p[q].x), bfhi(zk_p[q].x), bflo(zk_p[q].y), bfhi(zk_p[q].y)}; \
            const float av[4] = {bflo(aa[q].x), bfhi(aa[q].x), bflo(aa[q].y), bfhi(aa[q].y)}; \
            const float dc[4] = {(float)(dd[q].x & 0xffffu), (float)(dd[q].x >> 16), (float)(dd[q].y & 0xffffu), (float)(dd[q].y >> 16)}; \
            f32x4 R4, K4, W4, KK4, B4; float n2 = 0.f; \
            _Pragma("unroll") for (int e = 0; e < 4; ++e) { const float pr = first ? 0.f : rp[e], pk = first ? 0.f : kp_[e]; \
                const float r = rc[e] + (pr - rc[e]) * mu_r[e], k = kc[e] + (pk - kc[e]) * mu_k[e]; \
                R4[e] = r; W4[e] = 0.5f + dc[e] * (1.0f / 131070.0f); const float kkr = k * kkc[e]; KK4[e] = kkr; n2 += kkr * kkr; \
                K4[e] = k * (1.0f + (av[e] - 1.0f) * kac[e]); } \
            n2 = row16_sum(n2); const float invn = 1.0f / fmaxf(sqrtf(n2), 1e-12f); \
            _Pragma("unroll") for (int e = 0; e < 4; ++e) { KK4[e] *= invn; B4[e] = -KK4[e] * av[e]; } \
            const float vc = bf2f(zv_c[q]), vp = first ? 0.f : bf2f(zv_p[q]); \
            *(LAS f32x4*)(rec + 4 * jl) = W4; *(LAS f32x4*)(rec + 64 + 4 * jl) = KK4; *(LAS f32x4*)(rec + 128 + 4 * jl) = B4; *(LAS f32x4*)(rec + 192 + 4 * jl) = K4; *(LAS f32x4*)(rec + 256 + 4 * jl) = R4; \
            rec[320 + jl] = vc + (vp - vc) * mu_v; } } while (0)
        SC_ISSUE(0); SC_WRITE(0); SC_ISSUE(1);
        __syncthreads();
#pragma unroll 1
        for (int ch = 0; ch < SC_NCH; ++ch) {
            if (ch + 1 < SC_NCH) SC_WRITE(ch + 1);
            if (ch + 2 < SC_NCH) SC_ISSUE(ch + 2);
            __syncthreads();
        }
#undef SC_ISSUE
#undef SC_WRITE
    } else {
        const int rowl = 4 * wave + ts;
        f32x2 S01 = (f32x2){0.f, 0.f}, S23 = (f32x2){0.f, 0.f};
        bf16* yp = YR + h * 64 + i0 + rowl;
        __syncthreads();
#pragma unroll 1
        for (int ch = 0; ch < SC_NCH; ++ch) {
            const LAS float* cb = buf + (ch & 1) * (SC_TC * SC_REC);
#pragma unroll 4
            for (int tt = 0; tt < SC_TC; ++tt) {
                const LAS float* rec = cb + tt * SC_REC;
                const f32x4 W4 = *(const LAS f32x4*)(rec + 4 * jl), KK4 = *(const LAS f32x4*)(rec + 64 + 4 * jl), B4 = *(const LAS f32x4*)(rec + 128 + 4 * jl),
                            K4 = *(const LAS f32x4*)(rec + 192 + 4 * jl), R4 = *(const LAS f32x4*)(rec + 256 + 4 * jl);
                const float v = rec[320 + rowl];
                f32x2 p = S01 * (f32x2){KK4[0], KK4[1]}; p = S23 * (f32x2){KK4[2], KK4[3]} + p;
                const float sa = row16_sum(p.x + p.y);
                const f32x2 sa2 = (f32x2){sa, sa}, v2 = (f32x2){v, v};
                f32x2 t01 = (f32x2){K4[0], K4[1]} * v2, t23 = (f32x2){K4[2], K4[3]} * v2;
                t01 = (f32x2){B4[0], B4[1]} * sa2 + t01; t23 = (f32x2){B4[2], B4[3]} * sa2 + t23;
                S01 = S01 * (f32x2){W4[0], W4[1]} + t01; S23 = S23 * (f32x2){W4[2], W4[3]} + t23;
                f32x2 y2 = S01 * (f32x2){R4[0], R4[1]}; y2 = S23 * (f32x2){R4[2], R4[3]} + y2;
                const float y = row16_sum(y2.x + y2.y);
                if (jl == 0) yp[(size_t)(ch * SC_TC + tt) * 512] = (bf16)f2bf(y);
            }
            __syncthreads();
        }
    }
}

__device__ __forceinline__ void attn_static(const Args& a, unsigned char* lds_generic) {
    const int G = gridDim.x, bx = blockIdx.x; const int vcu = (G % 8 == 0) ? (bx % 8) * (G / 8) + bx / 8 : bx;
    const attn_body::bf16* zda = (const attn_body::bf16*)(a.ws + WS_ZDA); attn_body::bf16* O = (attn_body::bf16*)(a.ws + WS_XN);
    for (int v = vcu; v < 256; v += G) {
        const int bh = v >> 3, s = v & 7;
#pragma unroll 1
        for (int i = 0; i < 4; ++i) { const int qb = (i == 0) ? s : (i == 1) ? 15 - s : (i == 2) ? 16 + s : 31 - s;
            attn_body::attn_unit_vh<8>(bh >> 4, bh & 15, qb, zda, O, (char*)lds_generic); }
    }
}
__device__ __forceinline__ void attn_queue(const Args& a, unsigned char* lds_generic, LAS unsigned char* lds) {
    const attn_body::bf16* zda = (const attn_body::bf16*)(a.ws + WS_ZDA); attn_body::bf16* O = (attn_body::bf16*)(a.ws + WS_XN);
    unsigned* ctr = (unsigned*)(a.ws + WS_CTL);
    volatile LAS unsigned* slot = (volatile LAS unsigned*)(lds + 135168);
    for (;;) {
        __syncthreads();
        if (threadIdx.x == 0) *slot = __hip_atomic_fetch_add(ctr, 1u, __ATOMIC_RELAXED, __HIP_MEMORY_SCOPE_AGENT);
        __syncthreads();
        const unsigned u = __builtin_amdgcn_readfirstlane(*slot);
        if (u >= 1024u) break;
        const int qb = 31 - (int)(u >> 5), bvh = (int)(u & 31);
        attn_body::attn_unit_vh<8>(bvh >> 4, bvh & 15, qb, zda, O, (char*)lds_generic);
    }
}
__device__ __forceinline__ void post_da(const Args& a) {
    int tid_ = threadIdx.x; asm volatile("" : "+v"(tid_)); const int tid = tid_, lane = tid & 63, wave = tid >> 6;
    const int gw = blockIdx.x * NWAVES + wave, NGW = gridDim.x * NWAVES;
    const bf16* O = (const bf16*)(a.ws + WS_XN); bf16* dao = (bf16*)(a.ws + WS_DAO);
    float lam; { float s1 = 0.f, s2 = 0.f;
#pragma unroll 1
        for (int i = 0; i < 64; ++i) { s1 += a.in[15][i] * a.in[16][i]; s2 += a.in[17][i] * a.in[18][i]; } lam = expf(s1) - expf(s2) + LAMBDA_INIT; }
    const float g0 = a.in[19][2 * lane] * (1.0f - LAMBDA_INIT), g1 = a.in[19][2 * lane + 1] * (1.0f - LAMBDA_INIT);
    for (int unit = gw; unit < M * 4; unit += NGW) {
        const int t = unit >> 2, h = unit & 3;
        const unsigned w1 = *(const unsigned*)(O + (size_t)t * 1024 + h * 256 + 2 * lane), w2 = *(const unsigned*)(O + (size_t)t * 1024 + h * 256 + 128 + 2 * lane);
        const float o0 = bflo(w1) - lam * bflo(w2), o1 = bfhi(w1) - lam * bfhi(w2);
        const float rs = 1.0f / sqrtf(wave_sum(o0 * o0 + o1 * o1) * (1.0f / 128.0f) + 1e-5f);
        *(unsigned*)(dao + (size_t)t * 512 + h * 128 + 2 * lane) = pk2(o0 * rs * g0, o1 * rs * g1);
    }
}

__device__ __forceinline__ void post_rw(const Args& a) {
    int tid_ = threadIdx.x; asm volatile("" : "+v"(tid_)); const int tid = tid_, lane = tid & 63, wave = tid >> 6;
    const int gw = blockIdx.x * NWAVES + wave, NGW = gridDim.x * NWAVES;
    const bf16* zrw = (const bf16*)(a.ws + WS_ZRW);
    const bf16* AV = (const bf16*)((unsigned char*)a.out + DO_A); const bf16* GV = (const bf16*)((unsigned char*)a.out + DO_G);
    const bf16* YR = (const bf16*)((unsigned char*)a.out + DO_YRAW); bf16* RWO = (bf16*)((unsigned char*)a.out + DO_RWO);
    for (int unit = gw; unit < M * 8; unit += NGW) {
        const int t = unit >> 3, h = unit & 7, col = h * 64 + lane;
        const float y = bf2f(YR[(size_t)t * 512 + col]);
        const float mean = wave_sum(y) * (1.f / 64.f); const float dy = y - mean; const float var = wave_sum(dy * dy) * (1.f / 64.f);
        const float yn = dy * (1.0f / sqrtf(var + 64e-5f)) * a.in[12][col] + a.in[13][col];
        const float r = lerp_col(zrw, t, col, a.in[3][col]), k = lerp_col(zrw, t, 512 + col, a.in[3][512 + col]), v = lerp_col(zrw, t, 1024 + col, a.in[3][1024 + col]);
        const float av = bf2f(AV[(size_t)t * 512 + col]); const float kp = k * (1.0f + (av - 1.0f) * a.in[10][col]);
        const float rkb = wave_sum(r * kp * a.in[11][col]);
        const float o = (yn + rkb * v) * bf2f(GV[(size_t)t * 512 + col]);
        RWO[(size_t)t * 512 + col] = (bf16)f2bf(o);
    }
}

__device__ __forceinline__ void rows1(const Args& a) {
    int tid_ = threadIdx.x; asm volatile("" : "+v"(tid_)); const int tid = tid_, lane = tid & 63, wave = tid >> 6;
    const int gw = blockIdx.x * NWAVES + wave, NGW = gridDim.x * NWAVES;
    const float* Y = (const float*)(a.ws + WS_Y); bf16* H2 = (bf16*)(a.ws + WS_XN);
    for (int m = gw; m < M; m += NGW) {
        const f32x4* yr = (const f32x4*)(Y + (size_t)m * DM) + lane; const f32x4* xr = (const f32x4*)(a.in[0] + (size_t)m * DM) + lane;
        f32x4 v[4]; float s = 0.f;
#pragma unroll
        for (int j = 0; j < 4; ++j) { v[j] = yr[64 * j]; s += (v[j].x * v[j].x + v[j].y * v[j].y) + (v[j].z * v[j].z + v[j].w * v[j].w); }
        const float rs = 1.0f / sqrtf(wave_sum(s) * (1.f / DM) + 1e-6f); float s2 = 0.f;
#pragma unroll
        for (int j = 0; j < 4; ++j) { const f32x4 g = *(const f32x4*)(a.in[22] + 4 * lane + 256 * j); v[j] = xr[64 * j] + v[j] * rs * g; s2 += (v[j].x * v[j].x + v[j].y * v[j].y) + (v[j].z * v[j].z + v[j].w * v[j].w); }
        const float rs2 = 1.0f / sqrtf(wave_sum(s2) * (1.f / DM) + 1e-6f);
        f32x4* orow = (f32x4*)(a.out + (size_t)m * DM) + lane; v2u* h8 = (v2u*)(H2 + (size_t)m * DM) + lane;
#pragma unroll
        for (int j = 0; j < 4; ++j) { orow[64 * j] = v[j]; const f32x4 g = *(const f32x4*)(a.in[23] + 4 * lane + 256 * j);
            v2u w; w.x = pk2(v[j].x * rs2 * g.x, v[j].y * rs2 * g.y); w.y = pk2(v[j].z * rs2 * g.z, v[j].w * rs2 * g.w); h8[64 * j] = w; }
    }
}
__device__ __forceinline__ void rows2(const Args& a) {
    int tid_ = threadIdx.x; asm volatile("" : "+v"(tid_)); const int tid = tid_, lane = tid & 63, wave = tid >> 6;
    const int gw = blockIdx.x * NWAVES + wave, NGW = gridDim.x * NWAVES;
    const float* F = (const float*)(a.ws + WS_F);
    for (int m = gw; m < M; m += NGW) {
        const f32x4* fr = (const f32x4*)(F + (size_t)m * DM) + lane; f32x4* orow = (f32x4*)(a.out + (size_t)m * DM) + lane;
        f32x4 v[4]; float s = 0.f;
#pragma unroll
        for (int j = 0; j < 4; ++j) { v[j] = fr[64 * j]; s += (v[j].x * v[j].x + v[j].y * v[j].y) + (v[j].z * v[j].z + v[j].w * v[j].w); }
        const float rs = 1.0f / sqrtf(wave_sum(s) * (1.f / DM) + 1e-6f);
#pragma unroll
        for (int j = 0; j < 4; ++j) { const f32x4 g = *(const f32x4*)(a.in[26] + 4 * lane + 256 * j); orow[64 * j] = orow[64 * j] + v[j] * rs * g; }
    }
}

constexpr int NPH = 12;
template <int LO, int HI> __global__ void __launch_bounds__(NTHR, 2) mk_fwd(Args a) {
    extern __shared__ __attribute__((aligned(16))) unsigned char lds_raw[];
    LAS unsigned char* lds = (LAS unsigned char*)lds_raw;
    unsigned char* ws = a.ws;
    const int G = gridDim.x, c = blockIdx.x;
    constexpr int lo = LO, hi = HI;
#ifdef ONLY_PH
#define IN(k) ((k) == ONLY_PH && lo <= (k) && (k) < hi)
#else
#define IN(k) (lo <= (k) && (k) < hi)
#endif
#define SEAM(k) do { __syncthreads(); if ((k) + 1 < hi) cg::this_grid().sync(); } while (0)
    if (IN(0)) { p0_prologue(a, lds); SEAM(0); }
    if (IN(1)) { pg8::Gemm g{(const bf16*)(ws + WS_XN), (const bf16*)(ws + WS_WIN), M, IN_W, DM}; pg8::StaticOrder S; S.init(M, IN_W, G, c);
        EpiG1 E{(bf16*)(ws + WS_ZRW), (bf16*)(ws + WS_ZDA), (bf16*)(ws + WS_ZG)};
        pg8::gemm_phase<EpiG1, pg8::StaticOrder, true, true>(lds, g, S, E); SEAM(1); }
    if (IN(2)) { prep_a(a); SEAM(2); }
    if (IN(3)) { int k3 = 256; asm volatile("" : "+s"(k3)); pg8::Gemm g{(const bf16*)(ws + WS_XN), (const bf16*)(ws + WS_LORA), M, 1536, k3}; pg8::StaticOrder S; S.init(M, 1536, G, c);
        EpiLora E{(bf16*)((unsigned char*)a.out + DO_DEC), (bf16*)((unsigned char*)a.out + DO_A), (bf16*)((unsigned char*)a.out + DO_G), a.in[4], a.in[6]};
        pg8::gemm_phase<EpiLora, pg8::StaticOrder, true, true>(lds, g, S, E); SEAM(3); }
#ifdef SKEL_TEST
    if (IN(4)) { SEAM(4); }
#else
    if (IN(4)) { if (c < SCAN_BLOCKS) { scan_fast(a, lds); __syncthreads(); } attn_queue(a, lds_raw, lds); SEAM(4); }
#endif
    if (IN(5)) { post_rw(a); post_da(a); SEAM(5); }
    if (IN(6)) { pg8::StaticOrder S; S.init(M, DM, G, c);
        { pg8::Gemm g{(const bf16*)((unsigned char*)a.out + DO_RWO), (const bf16*)(ws + WS_WRW), M, DM, 512};
          EpiGate<0> E{(const bf16*)(ws + WS_ZG), 0, (float*)(ws + WS_Y), (bf16*)(ws + WS_MERGED)};
          pg8::gemm_phase<EpiGate<0>, pg8::StaticOrder, true, true>(lds, g, S, E); }
        __syncthreads();
        { pg8::Gemm g{(const bf16*)(ws + WS_DAO), (const bf16*)(ws + WS_WDA), M, DM, 512};
          EpiGate<1> E{(const bf16*)(ws + WS_ZG), DM, (float*)(ws + WS_Y), (bf16*)(ws + WS_MERGED)};
          pg8::gemm_phase<EpiGate<1>, pg8::StaticOrder, true, true>(lds, g, S, E); }
        SEAM(6); }
    if (IN(7)) { pg8::Gemm g{(const bf16*)(ws + WS_MERGED), (const bf16*)(ws + WS_WO), M, DM, DM}; pg8::StaticOrder S; S.init(M, DM, G, c);
        EpiF32 E{(float*)(ws + WS_Y), DM};
        pg8::gemm_phase<EpiF32, pg8::StaticOrder, true, true>(lds, g, S, E); SEAM(7); }
    if (IN(8)) { rows1(a); SEAM(8); }
    if (IN(9)) { pg8::Gemm g{(const bf16*)(ws + WS_XN), (const bf16*)(ws + WS_WUP), M, FF, DM}; pg8::StaticOrder S; S.init(M, FF, G, c);
        EpiRelu2 E{(bf16*)(ws + WS_H), FF};
        pg8::gemm_phase<EpiRelu2, pg8::StaticOrder, true, true>(lds, g, S, E); SEAM(9); }
    if (IN(10)) { pg8::Gemm g{(const bf16*)(ws + WS_H), (const bf16*)(ws + WS_WDN), M, DM, FF}; pg8::StaticOrder S; S.init(M, DM, G, c);
        EpiF32 E{(float*)(ws + WS_F), DM};
        pg8::gemm_phase<EpiF32, pg8::StaticOrder, true, true>(lds, g, S, E); SEAM(10); }
    if (IN(11)) { rows2(a); }
#undef IN
#undef SEAM
}

#ifndef MK_ONE_LAUNCH
#define MK_ONE_LAUNCH 1
#endif
template <int PH> static void launch_phases(const Args& a, int grid, hipStream_t stream) {
    hipLaunchKernelGGL((mk_fwd<PH, PH + 1>), dim3(grid), dim3(NTHR), LDS_BYTES, stream, a);
    if constexpr (PH + 1 < NPH) launch_phases<PH + 1>(a, grid, stream);
}
template <int PH> static bool set_lds_attr() {
    bool ok = hipFuncSetAttribute((const void*)mk_fwd<PH, PH + 1>, hipFuncAttributeMaxDynamicSharedMemorySize, LDS_BYTES) == hipSuccess;
    if constexpr (PH + 1 < NPH) ok = set_lds_attr<PH + 1>() && ok;
    return ok;
}
extern "C" void kernel_launch(void* const* d_in, const int* in_sizes, int n_in, void* d_out, int out_size, void* d_ws, size_t ws_size, hipStream_t stream) {
    static int grid = 0;
    if (grid == 0) {
        if (n_in != 27 || in_sizes[0] != M * DM || out_size != M * DM || ws_size < WS_END) { fprintf(stderr, "kernel_launch: unexpected shapes: n_in %d in0 %d out %d ws %zu\n", n_in, n_in > 0 ? in_sizes[0] : -1, out_size, ws_size); grid = -1; return; }
        int dev = 0, cus = 0;
        (void)hipGetDevice(&dev); (void)hipDeviceGetAttribute(&cus, hipDeviceAttributeMultiprocessorCount, dev);
#if MK_ONE_LAUNCH
        bool ok = hipFuncSetAttribute((const void*)mk_fwd<0, NPH>, hipFuncAttributeMaxDynamicSharedMemorySize, LDS_BYTES) == hipSuccess;
#elif defined(ONLY4)
        bool ok = true;
#else
        bool ok = set_lds_attr<0>();
#endif
        if (!ok) { fprintf(stderr, "kernel_launch: hipFuncSetAttribute failed\n"); grid = -1; return; }
        grid = cus;
    }
    if (grid < 0) return;
    (void)hipMemsetAsync((char*)d_ws + WS_CTL, 0, 4096, stream);
    Args a{};
    for (int i = 0; i < 27; ++i) a.in[i] = (const float*)d_in[i];
    a.out = (float*)d_out; a.ws = (unsigned char*)d_ws;
#if MK_ONE_LAUNCH
    void* args[] = {&a};
    hipError_t e = hipLaunchCooperativeKernel((const void*)mk_fwd<0, NPH>, dim3(grid), dim3(NTHR), args, LDS_BYTES, stream);
    if (e != hipSuccess) fprintf(stderr, "cooperative launch failed: %s (grid %d)\n", hipGetErrorString(e), grid);
#elif defined(ONLY4)
    hipLaunchKernelGGL((mk_fwd<4, 5>), dim3(grid), dim3(NTHR), LDS_BYTES, stream, a);
#else
    launch_phases<0>(a, grid, stream);
#endif
}
```

```cpp
#include <hip/hip_runtime.h>
#include <hip/hip_cooperative_groups.h>
#include <cstdio>
#include <cstdint>
#include <cmath>
namespace cg = cooperative_groups;
namespace pg8 {
#define PG8_LAS __attribute__((address_space(3)))
typedef unsigned short bf16_t;
typedef short bf16x8 __attribute__((ext_vector_type(8)));
typedef float f32x4 __attribute__((ext_vector_type(4)));
typedef unsigned u32x4 __attribute__((ext_vector_type(4)));
constexpr int BM = 256, BK = 64, HALF = 128, HTB = HALF * BK * 2  , STAGE_BYTES = 8 * HTB, NXCD = 8, WGM = 8;

__host__ __device__ __forceinline__ int lds_byte(int r, int c) { const int st = (r >> 4) * 2 + (c >> 5), rr = r & 15, cc = c & 31, ob = rr * 64 + cc * 2; return st * 1024 + (ob ^ (((ob >> 9) & 1) << 5)); }
__host__ __device__ __forceinline__ void stage_rc(int b, int& R, int& C) { const int st = b / 1024, sb = b % 1024, swz = sb ^ (((sb >> 9) & 1) << 5); R = (st >> 1) * 16 + swz / 64; C = (st & 1) * 32 + (swz % 64) / 2; }
__host__ __device__ __forceinline__ int perm32(int rho) { const int n = rho >> 4, i = rho & 15; return 8 * (i >> 2) + 4 * n + (i & 3); }

struct Unit { int pm, pn; };
struct Gemm { const bf16_t* A; const bf16_t* Bt; int M, N, K; };

struct StaticOrder {
    int nM, nN, nwg, G, c;
    __host__ __device__ void init(int M, int N, int G_, int c_) { nM = M / BM; nN = N / BM; nwg = nM * nN; G = G_; c = c_; }
    __host__ __device__ bool next(int i, Unit& u) const {
        const long L = (long)i * G + c; if (L >= nwg) return false;
        int wgid = (int)L; { const int q = nwg / NXCD, r = nwg % NXCD, xcd = wgid % NXCD, off = wgid / NXCD; wgid = (xcd < r ? xcd * (q + 1) : r * (q + 1) + (xcd - r) * q) + off; }
        const int nig = WGM * nN, gid = wgid / nig, fm = gid * WGM, gsz = (nM - fm) < WGM ? (nM - fm) : WGM;
        u.pm = fm + ((wgid % nig) % gsz); u.pn = (wgid % nig) / gsz; return true;
    }
    __device__ __forceinline__ void a_ready(const Unit&) const {}
    __device__ __forceinline__ void done(const Unit&) const {}
};

__device__ __forceinline__ unsigned cvt_pk_bf16(float lo, float hi) { unsigned r; asm volatile("v_cvt_pk_bf16_f32 %0, %1, %2" : "=v"(r) : "v"(lo), "v"(hi)); return r; }
typedef float f32x2 __attribute__((ext_vector_type(2)));
__device__ __forceinline__ f32x2 gelu_pk(f32x2 v) {
    const f32x2 av = __builtin_elementwise_abs(v), d = av * 0.2316418882f + 1.0f;
    f32x2 t; t.x = __builtin_amdgcn_rcpf(d.x); t.y = __builtin_amdgcn_rcpf(d.y);
    f32x2 q = t * 0.5307027145f + (-0.7265760135f); q = q * t + 0.7107068705f; q = q * t + (-0.142248368f); q = q * t + 0.127414796f; q = q * t;
    const f32x2 s = (v * v) * (-0.72134752044f);
    f32x2 e; e.x = __builtin_amdgcn_exp2f(s.x); e.y = __builtin_amdgcn_exp2f(s.y);
    const f32x2 m = v * (q * e), r = v - m;
    f32x2 o; o.x = v.x < 0.f ? m.x : r.x; o.y = v.y < 0.f ? m.y : r.y; return o;
}

template <int ACT  > struct EpiBf16 {
    static constexpr bool PERM = true, AFTER_DRAIN = false; static_assert(ACT == 0 || ACT == 1, "EpiBf16: ACT is 0 (none) or 1 (gelu_pk)");
    bf16_t* O; int ldc; const float* bias; int split_cols; size_t split_stride; float scale0;
    __device__ __forceinline__ void operator()(const f32x4 (&acc)[2][2][4][2], const Unit& u, int wr, int wc, int fr, int fq) const {
        const int row0 = u.pm * BM + wr * 64 + fr; int colt = u.pn * BM; bf16_t* base = O;
        float sc = 1.f; if (split_cols) { const int t = colt / split_cols; base += (size_t)t * split_stride; colt -= t * split_cols; if (t == 0) sc = scale0; }
        const int col0 = colt + wc * 32 + 8 * fq, bcol0 = u.pn * BM + wc * 32 + 8 * fq;
        f32x4 bv[2][2];
#pragma unroll
        for (int bj = 0; bj < 2; ++bj)
#pragma unroll
            for (int n = 0; n < 2; ++n) bv[bj][n] = bias ? *(const f32x4*)(bias + bcol0 + bj * HALF + 4 * n) : (f32x4){0.f, 0.f, 0.f, 0.f};
#pragma unroll
        for (int ai = 0; ai < 2; ++ai)
#pragma unroll
            for (int m = 0; m < 4; ++m) { bf16_t* rowp = base + (size_t)(row0 + ai * HALF + m * 16) * ldc + col0;
#pragma unroll
                for (int bj = 0; bj < 2; ++bj) { f32x4 v0 = acc[ai][bj][m][0] + bv[bj][0], v1 = acc[ai][bj][m][1] + bv[bj][1];
                    if (ACT == 1) { f32x2 a = gelu_pk((f32x2){v0[0], v0[1]}), b = gelu_pk((f32x2){v0[2], v0[3]}), c = gelu_pk((f32x2){v1[0], v1[1]}), d = gelu_pk((f32x2){v1[2], v1[3]});
                        v0 = (f32x4){a.x, a.y, b.x, b.y}; v1 = (f32x4){c.x, c.y, d.x, d.y}; }
                    v0 = v0 * sc; v1 = v1 * sc; u32x4 w; w.x = cvt_pk_bf16(v0[0], v0[1]); w.y = cvt_pk_bf16(v0[2], v0[3]); w.z = cvt_pk_bf16(v1[0], v1[1]); w.w = cvt_pk_bf16(v1[2], v1[3]);
                    *(u32x4*)(rowp + bj * HALF) = w; } }
    }
};

template <class Epi, class Sched, bool ALIGN_EPI = false, bool SP2 = false>
__device__ __forceinline__ void gemm_phase(PG8_LAS unsigned char* lds, const Gemm g, const Sched& S, const Epi& E) {
    int tid_ = threadIdx.x; asm volatile("" : "+v"(tid_));
    const int tid = tid_, wid = __builtin_amdgcn_readfirstlane(tid >> 6), lane = tid & 63, wr = wid >> 2, wc = wid & 3, fr = lane & 15, fq = lane >> 4;
    const int K = g.K, nt = K / BK;
    unsigned voffA[2], voffB[2];
#pragma unroll
    for (int i = 0; i < 2; ++i) { int R, C; stage_rc(tid * 16 + i * 8192, R, C); const int Rb = Epi::PERM ? ((R & ~31) + perm32(R & 31)) : R;
        voffA[i] = (unsigned)(R * K + C) * 2u; voffB[i] = (unsigned)(Rb * K + C) * 2u; }
    const size_t kstep = (size_t)(BK * 2);
    const size_t hstep = (size_t)HALF * K * 2;
    const size_t tstep = 2 * hstep;
    const unsigned ldsw = (unsigned)wid * 1024u;
    const int aoff = lds_byte(wr * 64 + fr, fq * 8), boff = lds_byte(wc * 32 + fr, fq * 8);
#define PG8_SA(b, h) (((b) * 2 + (h)) * HTB)
#define PG8_SB(b, h) ((4 + (b) * 2 + (h)) * HTB)
#define PG8_STAGE(bufoff, gbase, voff) do { _Pragma("unroll") for (int _i = 0; _i < 2; ++_i) \
        __builtin_amdgcn_global_load_lds((const unsigned*)((const char*)(gbase) + (voff)[_i]), (PG8_LAS unsigned*)(lds + (bufoff) + ldsw + _i * 8192), 16, 0, 0); } while (0)
#define PG8_LDA(dst, b, h) do { _Pragma("unroll") for (int m = 0; m < 4; ++m) _Pragma("unroll") for (int k = 0; k < 2; ++k) dst[m][k] = *(const PG8_LAS bf16x8*)(lds + PG8_SA(b, h) + aoff + m * 2048 + k * 1024); } while (0)
#define PG8_LDB(dst, b, h) do { _Pragma("unroll") for (int n = 0; n < 2; ++n) _Pragma("unroll") for (int k = 0; k < 2; ++k) dst[n][k] = *(const PG8_LAS bf16x8*)(lds + PG8_SB(b, h) + boff + n * 2048 + k * 1024); } while (0)
#define PG8_MMA(ai, bj, At, Bt) do { __builtin_amdgcn_s_setprio(1); _Pragma("unroll") for (int m = 0; m < 4; ++m) _Pragma("unroll") for (int n = 0; n < 2; ++n) _Pragma("unroll") for (int k = 0; k < 2; ++k) \
        acc[ai][bj][m][n] = __builtin_amdgcn_mfma_f32_16x16x32_bf16(Bt[n][k], At[m][k], acc[ai][bj][m][n], 0, 0, 0); __builtin_amdgcn_s_setprio(0); } while (0)
#define PG8_WAIT_V(n) asm volatile("s_waitcnt vmcnt(" #n ")" ::: "memory")
#define PG8_WAIT_L(n) asm volatile("s_waitcnt lgkmcnt(" #n ")" ::: "memory")
#define PG8_BAR __builtin_amdgcn_s_barrier()
#define PG8_SCHED __builtin_amdgcn_sched_barrier(0)
    Unit cur, nxt; int ui = 0;
    if (!S.next(0, cur)) return;
    f32x4 acc[2][2][4][2];
#pragma unroll
    for (int a = 0; a < 2; ++a)
#pragma unroll
        for (int b = 0; b < 2; ++b)
#pragma unroll
            for (int m = 0; m < 4; ++m)
#pragma unroll
                for (int n = 0; n < 2; ++n) acc[a][b][m][n] = (f32x4){0.f, 0.f, 0.f, 0.f};
    bf16x8 At[4][2], B0[2][2], B1[2][2];
    const char* cA = (const char*)g.A + (size_t)cur.pm * tstep; const char* cB = (const char*)g.Bt + (size_t)cur.pn * tstep;
    S.a_ready(cur);
    if constexpr (SP2) {
        PG8_STAGE(PG8_SB(0, 0), cB, voffB); PG8_STAGE(PG8_SB(0, 1), cB + hstep, voffB); PG8_STAGE(PG8_SA(0, 0), cA, voffA); PG8_STAGE(PG8_SA(0, 1), cA + hstep, voffA);
        if (wr == 1) PG8_BAR;
        PG8_WAIT_V(2); PG8_BAR;
        PG8_STAGE(PG8_SB(1, 0), cB + kstep, voffB); PG8_STAGE(PG8_SA(1, 0), cA + kstep, voffA); PG8_STAGE(PG8_SB(1, 1), cB + hstep + kstep, voffB);
        PG8_WAIT_V(6); PG8_BAR;
    } else {
        PG8_STAGE(PG8_SB(0, 0), cB, voffB); PG8_STAGE(PG8_SA(0, 0), cA, voffA); PG8_STAGE(PG8_SB(0, 1), cB + hstep, voffB); PG8_STAGE(PG8_SA(0, 1), cA + hstep, voffA);
        if (wr == 1) PG8_BAR;
        PG8_WAIT_V(4); PG8_BAR;
        PG8_STAGE(PG8_SB(1, 0), cB + kstep, voffB); PG8_STAGE(PG8_SA(1, 0), cA + kstep, voffA); PG8_STAGE(PG8_SB(1, 1), cB + hstep + kstep, voffB);
        PG8_WAIT_V(6); PG8_BAR;
    }
    for (;;) {
        const bool has_next = S.next(ui + 1, nxt);
        const char* nA = has_next ? (const char*)g.A + (size_t)nxt.pm * tstep : cA; const char* nB = has_next ? (const char*)g.Bt + (size_t)nxt.pn * tstep : cB;
        for (int t = 0; t < nt; t += 2) {
            const bool last = (t == nt - 2);
            const char* a1 = cA + (size_t)(t + 1) * kstep;
            const char* a2 = last ? nA : cA + (size_t)(t + 2) * kstep; const char* b2 = last ? nB : cB + (size_t)(t + 2) * kstep;
            const char* a3 = a2 + kstep; const char* b3 = b2 + kstep;
            if (last && has_next) S.a_ready(nxt);
            if constexpr (SP2) {
            PG8_LDB(B0, 0, 0); PG8_LDB(B1, 0, 1); PG8_SCHED; PG8_LDA(At, 0, 0); PG8_STAGE(PG8_SA(1, 1), a1 + hstep, voffA);
            PG8_WAIT_V(8); PG8_WAIT_L(0); PG8_BAR; PG8_MMA(0, 0, At, B0); PG8_MMA(0, 1, At, B1); PG8_BAR; PG8_SCHED;
            PG8_LDA(At, 0, 1); PG8_STAGE(PG8_SB(0, 0), b2, voffB); PG8_STAGE(PG8_SB(0, 1), b2 + hstep, voffB); PG8_STAGE(PG8_SA(0, 0), a2, voffA);
            PG8_WAIT_V(8); PG8_WAIT_L(0); PG8_BAR; PG8_MMA(1, 0, At, B0); PG8_MMA(1, 1, At, B1); PG8_BAR; PG8_SCHED;
            PG8_LDB(B0, 1, 0); PG8_LDB(B1, 1, 1); PG8_SCHED; PG8_LDA(At, 1, 0); PG8_STAGE(PG8_SA(0, 1), a2 + hstep, voffA);
            PG8_WAIT_V(8); PG8_WAIT_L(0); PG8_BAR; PG8_MMA(0, 0, At, B0); PG8_MMA(0, 1, At, B1); PG8_BAR; PG8_SCHED;
            PG8_LDA(At, 1, 1); PG8_STAGE(PG8_SB(1, 0), b3, voffB); PG8_STAGE(PG8_SB(1, 1), b3 + hstep, voffB); PG8_STAGE(PG8_SA(1, 0), a3, voffA);
            PG8_WAIT_V(8); PG8_WAIT_L(0); PG8_BAR; PG8_MMA(1, 0, At, B0); PG8_MMA(1, 1, At, B1); PG8_BAR; PG8_SCHED;
            } else {
            PG8_LDB(B0, 0, 0); PG8_SCHED; PG8_LDA(At, 0, 0); PG8_STAGE(PG8_SA(1, 1), a1 + hstep, voffA);
            PG8_WAIT_L(8); PG8_BAR; PG8_WAIT_L(0); PG8_MMA(0, 0, At, B0); PG8_BAR; PG8_SCHED;
            PG8_LDB(B1, 0, 1); PG8_STAGE(PG8_SB(0, 0), b2, voffB);
            PG8_BAR; PG8_WAIT_L(0); PG8_MMA(0, 1, At, B1); PG8_BAR;
            PG8_LDA(At, 0, 1); PG8_STAGE(PG8_SA(0, 0), a2, voffA);
            PG8_BAR; PG8_WAIT_L(0); PG8_MMA(1, 0, At, B0); PG8_BAR; PG8_SCHED;
            PG8_STAGE(PG8_SB(0, 1), b2 + hstep, voffB);
            PG8_WAIT_V(6); PG8_BAR; PG8_MMA(1, 1, At, B1); PG8_BAR;
            PG8_LDB(B0, 1, 0); PG8_SCHED; PG8_LDA(At, 1, 0); PG8_STAGE(PG8_SA(0, 1), a2 + hstep, voffA);
            PG8_WAIT_L(8); PG8_BAR; PG8_WAIT_L(0); PG8_MMA(0, 0, At, B0); PG8_BAR; PG8_SCHED;
            PG8_LDB(B1, 1, 1); PG8_STAGE(PG8_SB(1, 0), b3, voffB);
            PG8_BAR; PG8_WAIT_L(0); PG8_MMA(0, 1, At, B1); PG8_BAR;
            PG8_LDA(At, 1, 1); PG8_STAGE(PG8_SA(1, 0), a3, voffA);
            PG8_BAR; PG8_WAIT_L(0); PG8_MMA(1, 0, At, B0); PG8_BAR; PG8_SCHED;
            PG8_STAGE(PG8_SB(1, 1), b3 + hstep, voffB);
            PG8_WAIT_V(6); PG8_BAR; PG8_MMA(1, 1, At, B1); PG8_BAR;
            }
        }
        if constexpr (ALIGN_EPI) { if (wr == 0) PG8_BAR; }
        if constexpr (!Epi::AFTER_DRAIN) { E(acc, cur, wr, wc, fr, fq); S.done(cur); }
        if (!has_next) break;
#pragma unroll
        for (int a = 0; a < 2; ++a)
#pragma unroll
            for (int b = 0; b < 2; ++b)
#pragma unroll
                for (int m = 0; m < 4; ++m)
#pragma unroll
                    for (int n = 0; n < 2; ++n) acc[a][b][m][n] = (f32x4){0.f, 0.f, 0.f, 0.f};
        cur = nxt; cA = nA; cB = nB; ++ui;
        if constexpr (ALIGN_EPI) { if (wr == 1) PG8_BAR; }
    }
    PG8_WAIT_V(0);
    if constexpr (!ALIGN_EPI) { if (wr == 0) PG8_BAR; }
    PG8_BAR;
    if constexpr (Epi::AFTER_DRAIN) { E.fused(acc, cur, wr, wc, fr, fq, lds, wid, lane); S.done(cur); }
#undef PG8_SA
#undef PG8_SB
#undef PG8_STAGE
#undef PG8_LDA
#undef PG8_LDB
#undef PG8_MMA
#undef PG8_WAIT_V
#undef PG8_WAIT_L
#undef PG8_BAR
#undef PG8_SCHED
}
}
#include <hip/hip_bf16.h>
#include <cmath>
namespace attn_body {
using bf16=__hip_bfloat16;
using bf16x8=__attribute__((ext_vector_type(8)))short;
using s16x4=__attribute__((ext_vector_type(4)))short;
using f32x16=__attribute__((ext_vector_type(16)))float;
using u32x4=__attribute__((ext_vector_type(4)))unsigned;
constexpr int BATCH=2,NHEAD=16,SEQ=8192,D=64,DM=1536,OP=1024;
constexpr int NW=8,QBLK=32,QB=QBLK*NW,KVBLK=64,NQB=SEQ/QB;
constexpr int ATTN_PITCH=DM, ATTN_UNIT_ROWS=QB;
__device__ __forceinline__ int crow(int r,int hi){return (r&3)+8*(r>>2)+4*hi;}
#define SBAR() __builtin_amdgcn_sched_barrier(0)
__device__ __forceinline__ void cmask(f32x16&p0,f32x16&p1,int jb,int qrel,int hi){
  const float NEG=-INFINITY; int kb=64*jb+4*hi; const int ql=qrel|63;
  #pragma unroll
  for(int r=0;r<16;++r){int kv=kb+(r&3)+8*(r>>2); if(kv>ql)p0[r]=NEG; if(kv+32>ql)p1[r]=NEG;}
}

constexpr int NSLOT=3, SLOTB=8192;
constexpr int LDS_K=0, LDS_V=NSLOT*SLOTB, LDS_WS=2*NSLOT*SLOTB, LDS_OST=LDS_WS+NW*64*4, LDS_BYTES=LDS_OST+NW*4096;
constexpr float C2=0.125f*1.4426950408889634f;
__device__ __forceinline__ void glds16(const void*gsrc,unsigned lds_dst){unsigned keep;
  asm volatile("s_mov_b32 %0, m0\n\ts_mov_b32 m0, %2\n\ts_nop 0\n\tglobal_load_lds_dwordx4 %1, off\n\ts_mov_b32 m0, %0":"=&s"(keep):"v"(gsrc),"s"(lds_dst):"memory");}
__device__ __forceinline__ float max3f(float a,float b,float c){float r;asm("v_max3_f32 %0, %1, %2, %3":"=v"(r):"v"(a),"v"(b),"v"(c));return r;}
__device__ __forceinline__ float max2f(float a,float b){float r;asm("v_max_f32_e32 %0, %1, %2":"=v"(r):"v"(a),"v"(b));return r;}
__device__ __forceinline__ float fadd_s(float a,float b){float r;asm("v_add_f32_e32 %0, %1, %2":"=v"(r):"v"(a),"v"(b));return r;}
__device__ __forceinline__ float fsub_s(float a,float b){float r;asm("v_sub_f32_e32 %0, %1, %2":"=v"(r):"v"(a),"v"(b));return r;}
typedef float f32x2_t __attribute__((ext_vector_type(2))); typedef __bf16 bf16x2_t __attribute__((ext_vector_type(2)));
__device__ __forceinline__ unsigned cvtpk_s(float lo,float hi){f32x2_t v={lo,hi};bf16x2_t b=__builtin_convertvector(v,bf16x2_t);return __builtin_bit_cast(unsigned,b);}
#define WAIT_BAR(N) asm volatile("s_waitcnt vmcnt(" #N ") lgkmcnt(0)\n\ts_barrier":::"memory")

__device__ __forceinline__ void qkt(f32x16&p0,f32x16&p1,const char*Kslot,const bf16x8*qr,const f32x16&negm,int r32,int hi){
  const char*kb=Kslot+hi*1024+r32*16;
  #pragma unroll
  for(int d0=0;d0<4;++d0){
    const bf16x8 b0=*reinterpret_cast<const bf16x8*>(kb+d0*2048);
    const bf16x8 b1=*reinterpret_cast<const bf16x8*>(kb+d0*2048+512);
    if(d0==0){p0=__builtin_amdgcn_mfma_f32_32x32x16_bf16(b0,qr[0],negm,0,0,0);p1=__builtin_amdgcn_mfma_f32_32x32x16_bf16(b1,qr[0],negm,0,0,0);}
    else{p0=__builtin_amdgcn_mfma_f32_32x32x16_bf16(b0,qr[d0],p0,0,0,0);p1=__builtin_amdgcn_mfma_f32_32x32x16_bf16(b1,qr[d0],p1,0,0,0);}}
}
typedef __attribute__((address_space(3))) const char* lds_cptr;
typedef short v4i16_t __attribute__((ext_vector_type(4)));
__device__ __forceinline__ void kload8(bf16x8*kf,lds_cptr kp){
  kf[0]=*(const __attribute__((address_space(3))) bf16x8*)(kp);      kf[1]=*(const __attribute__((address_space(3))) bf16x8*)(kp+512);
  kf[2]=*(const __attribute__((address_space(3))) bf16x8*)(kp+2048); kf[3]=*(const __attribute__((address_space(3))) bf16x8*)(kp+2560);
  kf[4]=*(const __attribute__((address_space(3))) bf16x8*)(kp+4096); kf[5]=*(const __attribute__((address_space(3))) bf16x8*)(kp+4608);
  kf[6]=*(const __attribute__((address_space(3))) bf16x8*)(kp+6144); kf[7]=*(const __attribute__((address_space(3))) bf16x8*)(kp+6656);
}
__device__ __forceinline__ void kload2(bf16x8*kf,lds_cptr kp,int j){ kf[2*j]=*(const __attribute__((address_space(3))) bf16x8*)(kp+j*2048); kf[2*j+1]=*(const __attribute__((address_space(3))) bf16x8*)(kp+j*2048+512); }
__device__ __forceinline__ s16x4 vtr(lds_cptr p){ return __builtin_bit_cast(s16x4,__builtin_amdgcn_ds_read_tr16_b64_v4i16((__attribute__((address_space(3))) v4i16_t*)p)); }
__device__ __forceinline__ float rowmax(const f32x16&p0,const f32x16&p1){
  float a=max3f(p0[0],p0[1],p1[0]),b=max3f(p0[2],p0[3],p1[1]);a=max3f(a,p1[2],p1[3]);
  #pragma unroll
  for(int r=4;r<16;r+=4){a=max3f(a,p0[r],p0[r+1]);b=max3f(b,p0[r+2],p0[r+3]);a=max3f(a,p1[r],p1[r+1]);b=max3f(b,p1[r+2],p1[r+3]);}
  const float m=max2f(a,b);
  auto rr=__builtin_amdgcn_permlane32_swap(__float_as_uint(m),__float_as_uint(m),false,false);
  return max2f(__uint_as_float(rr[0]),__uint_as_float(rr[1]));
}
__device__ __forceinline__ void pv(f32x16*o,int vb,bf16x8 pa0,bf16x8 pa1,bf16x8 pa2,bf16x8 pa3){
  #pragma unroll
  for(int d0=0;d0<2;++d0){s16x4 lo[4],hi[4];
    #pragma unroll
    for(int ks=0;ks<4;++ks){
      asm volatile("ds_read_b64_tr_b16 %0,%1 offset:%c2":"=&v"(lo[ks]):"v"(vb),"i"(d0*4096+ks*1024):"memory");
      asm volatile("ds_read_b64_tr_b16 %0,%1 offset:%c2":"=&v"(hi[ks]):"v"(vb),"i"(d0*4096+ks*1024+512):"memory");}
    asm volatile("s_waitcnt lgkmcnt(0)":::"memory");SBAR();
    #define PK(k) (bf16x8){lo[k][0],lo[k][1],lo[k][2],lo[k][3],hi[k][0],hi[k][1],hi[k][2],hi[k][3]}
    o[d0]=__builtin_amdgcn_mfma_f32_32x32x16_bf16(pa0,PK(0),o[d0],0,0,0);
    o[d0]=__builtin_amdgcn_mfma_f32_32x32x16_bf16(pa1,PK(1),o[d0],0,0,0);
    o[d0]=__builtin_amdgcn_mfma_f32_32x32x16_bf16(pa2,PK(2),o[d0],0,0,0);
    o[d0]=__builtin_amdgcn_mfma_f32_32x32x16_bf16(pa3,PK(3),o[d0],0,0,0);
    #undef PK
  }
}

#ifndef ATTN_STORE16
#define ATTN_STORE16(p,v) (*(u32x4*)(p)=(v))
#endif
template<int THRL> __device__ __forceinline__ void attn_unit(int b,int qb,const bf16*Q,const bf16*__restrict__ K,const bf16*__restrict__ V,bf16*O,char*shm){
  int tid_=threadIdx.x; asm volatile("":"+v"(tid_));
  const int tid=tid_,lane=tid&63,r32=lane&31,hi=lane>>5; const int wid=__builtin_amdgcn_readfirstlane(tid>>6);
  const long rowbase=(long)b*SEQ; const int q0=qb*QB;
  const bf16*Qw=Q+(rowbase+q0+wid*QBLK)*DM;
  const bf16*Kh=K+rowbase*DM,*Vh=V+rowbase*DM;
  const unsigned lds0=(unsigned)(uintptr_t)shm;
  float*wsf=(float*)(shm+LDS_WS)+wid*64;
  const bf16*ksrc=Kh+(long)lane*DM+wid*8;
  const bf16*vsrc=Vh+(long)(16*(wid&3)+(lane>>2))*DM+(wid>>2)*32+(lane&3)*8;
  const unsigned kdst=lds0+LDS_K+wid*1024, vdst=lds0+LDS_V+wid*1024;
  #define DMA_K(t,slot) glds16(ksrc+(long)(t)*KVBLK*DM,(unsigned)__builtin_amdgcn_readfirstlane(kdst+(slot)))
  #define DMA_V(t,slot) glds16(vsrc+(long)(t)*KVBLK*DM,(unsigned)__builtin_amdgcn_readfirstlane(vdst+(slot)))
  const int vb0=(int)(lds0+LDS_V)+((lane>>4)&1)*32+(lane&3)*8+(4*hi+((lane&15)>>2))*64;
  const char*Kbase=shm+LDS_K; bf16x8 kf[8];
  const lds_cptr shm3=(lds_cptr)shm; const lds_cptr kp0=shm3+LDS_K+hi*1024+r32*16; const lds_cptr vp0=shm3+LDS_V+((lane>>4)&1)*32+(lane&3)*8+(4*hi+((lane&15)>>2))*64;
  const int NT=(q0+QB)/KVBLK;
  DMA_K(0,0);DMA_V(0,0);DMA_K(1,SLOTB);
  bf16x8 qr[4];
  #pragma unroll
  for(int d0=0;d0<4;++d0)qr[d0]=*reinterpret_cast<const bf16x8*>(&Qw[(long)r32*DM+d0*16+hi*8]);
  float mhat=0.f,l_reg=0.f;f32x16 o[2];o[0]=f32x16{};o[1]=f32x16{};f32x16 negm=f32x16{};asm volatile("":"+v"(negm));
  const int qrel=wid*QBLK+r32;
  #define CMASK(P0,P1,t) do{int jb_=(t)-(NT-4); if(jb_>=0)cmask(P0,P1,jb_,qrel,hi);}while(0)
  bool resc=false;
  #define START(P0,P1) do{ const float rm=rowmax(P0,P1); resc=false; \
    { const float dl=rm; mhat=fadd_s(mhat,dl); \
      _Pragma("unroll") for(int r=0;r<16;++r){P0[r]=fsub_s(P0[r],dl);P1[r]=fsub_s(P1[r],dl);} \
      _Pragma("unroll") for(int r=0;r<16;++r)negm[r]=-mhat; asm volatile("":"+v"(negm)); } \
    _Pragma("unroll") for(int r=0;r<16;++r)P0[r]=__builtin_amdgcn_exp2f(P0[r]); }while(0)
  #define RESC() do{ if(resc){ asm volatile("s_waitcnt lgkmcnt(0)":::"memory"); \
      _Pragma("unroll") for(int d_=0;d_<2;++d_) _Pragma("unroll") for(int r=0;r<16;++r)o[d_][r]*=wsf[crow(r,hi)]; } }while(0)
  f32x16 pA0,pA1,pB0,pB1;
  int sl_prev=0,sl_cur=0,sl_next=SLOTB;
  #define ROT() do{sl_prev=sl_cur;sl_cur=sl_next;sl_next=(sl_next==(NSLOT-1)*SLOTB)?0:sl_next+SLOTB;}while(0)
  DMA_K(2,2*SLOTB);
  WAIT_BAR(3);
  qkt(pA0,pA1,Kbase,qr,negm,r32,hi);asm volatile("s_nop 15\n\ts_nop 7":"+v"(pA0),"+v"(pA1));CMASK(pA0,pA1,0);
  START(pA0,pA1);
  _Pragma("unroll") for(int r=0;r<16;++r)pA1[r]=__builtin_amdgcn_exp2f(pA1[r]);
  WAIT_BAR(0);
  DMA_K(3,0);DMA_V(1,SLOTB);
  ROT();
  kload8(kf,kp0+sl_cur);
  WAIT_BAR(2);
  s16x4 vlo[8],vhi[8]; u32x4 pw0,pw1,pw2,pw3;
  #define PKW(P,B) cvtpk_s(P[B],P[B+1])
  #define PAF(k) __builtin_bit_cast(bf16x8,pw##k)
  #define VFR(i) (bf16x8){vlo[i][0],vlo[i][1],vlo[i][2],vlo[i][3],vhi[i][0],vhi[i][1],vhi[i][2],vhi[i][3]}
  #define PIN(x) asm volatile("":"+v"(x))
  #define MX3(a,b,c) __builtin_fmaxf(__builtin_fmaxf((a),(b)),(c))
  #define GAPA(MF,A0,A1,A2,A3,W0,W1,PW) do{ MF; sacc+=A0; sacc+=A1; sacc+=A2; sacc+=A3; PIN(sacc); W0; W1; PIN(PW); SBAR(); }while(0)
  #define EX(v) __builtin_amdgcn_exp2f(v)
  #define GAPB(MF,X,B) do{ MF; X[B]=EX(X[B]); X[B+1]=EX(X[B+1]); X[B+2]=EX(X[B+2]); X[B+3]=EX(X[B+3]); PIN(X); SBAR(); }while(0)
  #define VRD(i) do{ vlo[i]=vtr(vp_+(((i)>>2)*4096+((i)&3)*1024)); vhi[i]=vtr(vp_+(((i)>>2)*4096+((i)&3)*1024+512)); }while(0)
  #define KRD(G,j) do{ if(G){ kload2(kf,kp0+sl_next,j); SBAR(); } }while(0)
  #define STEP(C0,C1,P0,P1,t,GK,GV,GL) do{ SBAR(); \
    const lds_cptr vp_=vp0+sl_prev; \
    VRD(0); SBAR(); float sacc=(P0[0]+P0[1]); \
    GAPA(C0=__builtin_amdgcn_mfma_f32_32x32x16_bf16(kf[0],qr[0],negm,0,0,0), P0[2],P0[3],P0[4],P0[5],     pw0[0]=PKW(P0,0), pw0[1]=PKW(P0,2), pw0); \
    VRD(4); SBAR(); GAPA(C1=__builtin_amdgcn_mfma_f32_32x32x16_bf16(kf[1],qr[0],negm,0,0,0), P0[6],P0[7],P0[8],P0[9],     pw0[2]=PKW(P0,4), pw0[3]=PKW(P0,6), pw0); \
    VRD(1); SBAR(); GAPA(C0=__builtin_amdgcn_mfma_f32_32x32x16_bf16(kf[2],qr[1],C0,0,0,0),   P0[10],P0[11],P0[12],P0[13], pw1[0]=PKW(P0,8), pw1[1]=PKW(P0,10), pw1); \
    VRD(5); SBAR(); GAPA(C1=__builtin_amdgcn_mfma_f32_32x32x16_bf16(kf[3],qr[1],C1,0,0,0),   P0[14],P0[15],P1[0],P1[1],   pw1[2]=PKW(P0,12),pw1[3]=PKW(P0,14), pw1); \
    VRD(2); SBAR(); GAPA(C0=__builtin_amdgcn_mfma_f32_32x32x16_bf16(kf[4],qr[2],C0,0,0,0),   P1[2],P1[3],P1[4],P1[5],     pw2[0]=PKW(P1,0), pw2[1]=PKW(P1,2), pw2); \
    VRD(6); SBAR(); GAPA(C1=__builtin_amdgcn_mfma_f32_32x32x16_bf16(kf[5],qr[2],C1,0,0,0),   P1[6],P1[7],P1[8],P1[9],     pw2[2]=PKW(P1,4), pw2[3]=PKW(P1,6), pw2); \
    VRD(3); SBAR(); GAPA(C0=__builtin_amdgcn_mfma_f32_32x32x16_bf16(kf[6],qr[3],C0,0,0,0),   P1[10],P1[11],P1[12],P1[13], pw3[0]=PKW(P1,8), pw3[1]=PKW(P1,10), pw3); \
    VRD(7); SBAR(); GAPA(C1=__builtin_amdgcn_mfma_f32_32x32x16_bf16(kf[7],qr[3],C1,0,0,0),   P1[14],P1[15],0.f,0.f,       pw3[2]=PKW(P1,12),pw3[3]=PKW(P1,14), pw3); \
    l_reg+=sacc; \
    if(GK){DMA_K((t)+3,sl_cur);} if(GV){DMA_V((t)+1,sl_next);} \
    CMASK(C0,C1,t); \
    { float a=MX3(C0[0],C0[1],C1[0]),b=MX3(C0[2],C0[3],C1[1]); a=MX3(a,C1[2],C1[3]); \
      _Pragma("unroll") for(int r=4;r<16;r+=4){a=MX3(a,C0[r],C0[r+1]);b=MX3(b,C0[r+2],C0[r+3]);a=MX3(a,C1[r],C1[r+1]);b=MX3(b,C1[r+2],C1[r+3]);} \
      float rm=__builtin_fmaxf(a,b); { auto rr=__builtin_amdgcn_permlane32_swap(__float_as_uint(rm),__float_as_uint(rm),false,false); rm=__builtin_fmaxf(__uint_as_float(rr[0]),__uint_as_float(rr[1])); } \
      resc=false; \
      if(__builtin_expect(__any(rm>(float)THRL),0)){ const float dl=__builtin_fmaxf(rm,0.f); mhat+=dl; \
        _Pragma("unroll") for(int r=0;r<16;++r){C0[r]-=dl;C1[r]-=dl;} \
        _Pragma("unroll") for(int r=0;r<16;++r)negm[r]=-mhat; asm volatile("":"+v"(negm)); \
        const float f=__builtin_amdgcn_exp2f(-dl); l_reg*=f; if(hi==0)wsf[r32]=f; resc=true; } } \
    SBAR(); \
    GAPB(o[0]=__builtin_amdgcn_mfma_f32_32x32x16_bf16(PAF(0),VFR(0),o[0],0,0,0), C0,0); \
    GAPB(o[1]=__builtin_amdgcn_mfma_f32_32x32x16_bf16(PAF(0),VFR(4),o[1],0,0,0), C0,4); \
    KRD(GL,0); GAPB(o[0]=__builtin_amdgcn_mfma_f32_32x32x16_bf16(PAF(1),VFR(1),o[0],0,0,0), C0,8); \
    KRD(GL,1); GAPB(o[1]=__builtin_amdgcn_mfma_f32_32x32x16_bf16(PAF(1),VFR(5),o[1],0,0,0), C0,12); \
    KRD(GL,2); GAPB(o[0]=__builtin_amdgcn_mfma_f32_32x32x16_bf16(PAF(2),VFR(2),o[0],0,0,0), C1,0); \
    KRD(GL,3); GAPB(o[1]=__builtin_amdgcn_mfma_f32_32x32x16_bf16(PAF(2),VFR(6),o[1],0,0,0), C1,4); \
    GAPB(o[0]=__builtin_amdgcn_mfma_f32_32x32x16_bf16(PAF(3),VFR(3),o[0],0,0,0), C1,8); \
    GAPB(o[1]=__builtin_amdgcn_mfma_f32_32x32x16_bf16(PAF(3),VFR(7),o[1],0,0,0), C1,12); \
    }while(0)
  int t=1;
  #undef CMASK
  #define CMASK(P0,P1,t) do{}while(0)
  for(;t+5<NT;t+=2){
    STEP(pB0,pB1,pA0,pA1,t,true,true,true);     WAIT_BAR(2); RESC(); ROT();
    STEP(pA0,pA1,pB0,pB1,t+1,true,true,true);   WAIT_BAR(2); RESC(); ROT();
  }
  #undef CMASK
  #define CMASK(P0,P1,t) do{int jb_=(t)-(NT-4); if(jb_>=0)cmask(P0,P1,jb_,qrel,hi);}while(0)
  #define ENDW(tt) do{ if((tt)+3<NT){WAIT_BAR(2);} else if((tt)+2<NT){WAIT_BAR(1);} else {WAIT_BAR(0);} }while(0)
  for(;t+1<NT;t+=2){
    STEP(pB0,pB1,pA0,pA1,t,(t+3<NT),(t+1<NT),(t+1<NT));       ENDW(t);   RESC(); ROT();
    STEP(pA0,pA1,pB0,pB1,t+1,(t+4<NT),(t+2<NT),(t+2<NT));     ENDW(t+1); RESC(); ROT();
  }
  STEP(pB0,pB1,pA0,pA1,NT-1,false,false,false); RESC();
  { float sacc=pB0[0]+pB0[1]; _Pragma("unroll") for(int r=2;r<16;++r)sacc+=pB0[r]; _Pragma("unroll") for(int r=0;r<16;++r)sacc+=pB1[r]; l_reg+=sacc;
    pw0=(u32x4){PKW(pB0,0),PKW(pB0,2),PKW(pB0,4),PKW(pB0,6)};pw1=(u32x4){PKW(pB0,8),PKW(pB0,10),PKW(pB0,12),PKW(pB0,14)};pw2=(u32x4){PKW(pB1,0),PKW(pB1,2),PKW(pB1,4),PKW(pB1,6)};pw3=(u32x4){PKW(pB1,8),PKW(pB1,10),PKW(pB1,12),PKW(pB1,14)};
    SBAR(); pv(o,vb0+sl_cur,PAF(0),PAF(1),PAF(2),PAF(3)); }
  #undef PKW
  #undef PAF
  #undef VFR
  #undef PIN
  #undef MX3
  #undef GAPA
  #undef GAPB
  #undef EX
  #undef VRD
  #undef KRD
  #undef STEP
  #undef ENDW
  {auto rr=__builtin_amdgcn_permlane32_swap(__float_as_uint(l_reg),__float_as_uint(l_reg),false,false);l_reg=__uint_as_float(rr[0])+__uint_as_float(rr[1]);}
  if(hi==0)wsf[32+r32]=l_reg;asm volatile("s_waitcnt lgkmcnt(0)":::"memory");
  float rli[16];
  #pragma unroll
  for(int r=0;r<16;++r)rli[r]=__builtin_amdgcn_rcpf(wsf[32+crow(r,hi)]);
  bf16*Ow=O+(rowbase+q0+wid*QBLK)*OP;
  { bf16*stg=(bf16*)(shm+LDS_OST)+wid*2048;
    #pragma unroll
    for(int r=0;r<16;++r){const int orow=crow(r,hi);
      #pragma unroll
      for(int d0=0;d0<2;++d0)stg[orow*64+d0*32+r32]=__float2bfloat16(o[d0][r]*rli[r]);}
    asm volatile("s_waitcnt lgkmcnt(0)":::"memory");
    #pragma unroll
    for(int i=0;i<4;++i){const int row=i*8+(lane>>3),ch=lane&7; const u32x4 v=*(const u32x4*)(stg+row*64+ch*8); ATTN_STORE16(Ow+(long)row*OP+ch*8,v);} }
  asm volatile("s_waitcnt lgkmcnt(0)\n\ts_barrier":::"memory");
  #undef DMA_K
  #undef DMA_V
  #undef CMASK
  #undef START
  #undef RESC
  #undef ROT
}
constexpr int ATTN_LDS_BYTES=LDS_BYTES;
template<int THRL=8> __device__ __forceinline__ void attn_unit_vh(int b,int vh,int qb,const bf16*zda,bf16*O,char*lds){
  const int h=vh>>2,m=(vh>>1)&1,half=vh&1;
  attn_unit<THRL>(b,qb,zda+(h*2+m)*64,zda+512+(h*2+m)*64,zda+1024+h*128+half*64,O+vh*64,lds);
}
#undef SBAR
#undef WAIT_BAR
}

constexpr int BATCH = 2, SEQ = 8192, DM = 1024, M = BATCH * SEQ, FF = 4096;
constexpr int RW_IN = 1792, DA_IN = 1536, GATE_IN = 2048, IN_W = 5376;
constexpr float C2 = 0.125f * 1.4426950408889634f;
constexpr float LAMBDA_INIT = 0.2f;
constexpr size_t KiB = 1024, MiB = 1u << 20;
constexpr size_t WS_CTL = 0;
constexpr size_t WS_WIN = 256 * KiB;
constexpr size_t WS_WRW = WS_WIN + (size_t)IN_W * DM * 2;
constexpr size_t WS_WDA = WS_WRW + 1 * MiB;
constexpr size_t WS_WO = WS_WDA + 1 * MiB;
constexpr size_t WS_WUP = WS_WO + 2 * MiB;
constexpr size_t WS_WDN = WS_WUP + 8 * MiB;
constexpr size_t WS_LORA = WS_WDN + 8 * MiB;
constexpr size_t WS_XN = WS_LORA + 768 * KiB;
constexpr size_t WS_ZRW = WS_XN + 32 * MiB;
constexpr size_t WS_ZDA = WS_ZRW + 56 * MiB;
constexpr size_t WS_ZG = WS_ZDA + 48 * MiB;
constexpr size_t WS_DAO = WS_ZG + 64 * MiB;
constexpr size_t WS_MERGED = WS_ZRW;
constexpr size_t WS_Y = WS_MERGED + 32 * MiB;
constexpr size_t WS_H = WS_ZRW;
constexpr size_t WS_F = WS_H + 128 * MiB;
constexpr size_t WS_END = WS_F + 64 * MiB;
static_assert(WS_XN == 32256 * KiB, "map");
static_assert(WS_DAO + 16 * MiB <= 256 * MiB && WS_END <= 256 * MiB, "d_ws map");
constexpr size_t DO_DEC = 0, DO_A = 16 * MiB, DO_G = 32 * MiB, DO_YRAW = 48 * MiB, DO_RWO = 0;

#define LAS __attribute__((address_space(3)))
typedef unsigned short bf16;
typedef unsigned v4u __attribute__((ext_vector_type(4)));
typedef unsigned v2u __attribute__((ext_vector_type(2)));
typedef float f32x4 __attribute__((ext_vector_type(4)));
constexpr int NWAVES = 8, NTHR = 512;
constexpr int LDS_BYTES = 147456;

__device__ __forceinline__ float bf2f(unsigned b) { return __uint_as_float(b << 16); }
__device__ __forceinline__ float bflo(unsigned w) { return __uint_as_float(w << 16); }
__device__ __forceinline__ float bfhi(unsigned w) { return __uint_as_float(w & 0xffff0000u); }
__device__ __forceinline__ unsigned f2bf(float f) { unsigned u = __float_as_uint(f); return (u + 0x7fffu + ((u >> 16) & 1u)) >> 16; }
__device__ __forceinline__ unsigned pk2(float lo, float hi) { return f2bf(lo) | (f2bf(hi) << 16); }
__device__ __forceinline__ float sigmoidf_(float x) { return 1.0f / (1.0f + __expf(-x)); }
__device__ __forceinline__ float wave_sum(float v) {
#pragma unroll
    for (int o = 1; o < 64; o <<= 1) v += __shfl_xor(v, o);
    return v;
}
__device__ __forceinline__ float wave_max(float v) {
#pragma unroll
    for (int o = 1; o < 64; o <<= 1) v = fmaxf(v, __shfl_xor(v, o));
    return v;
}

#define XB_TMO      128
#define XB_XCNT(j)  (256  + 64 * (j))
#define XB_XSUB(j)  (1280 + 64 * (j))
#define XB_XGEN(j)  (2304 + 64 * (j))
#define XB_TOP      3328
#define XB_TOPGEN   3392
#define XCD_BAR_WORDS 3456
#define XB_SPIN_CAP (1u << 18)

__device__ __forceinline__ unsigned xb_ld(unsigned* p)              { return __hip_atomic_load(p, __ATOMIC_RELAXED, __HIP_MEMORY_SCOPE_AGENT); }
__device__ __forceinline__ unsigned xb_add(unsigned* p, unsigned v) { return __hip_atomic_fetch_add(p, v, __ATOMIC_RELAXED, __HIP_MEMORY_SCOPE_AGENT); }
__device__ __forceinline__ unsigned xb_xcc_id() { return (unsigned)__builtin_amdgcn_s_getreg((3 << 11) | 20) & 0xFu; }
#define XB_SPIN(cond, bar) do { unsigned _sp = 0; while (cond) { __builtin_amdgcn_s_sleep(1); \
    if ((++_sp & 255u) == 0u) { if (xb_ld(&(bar)[XB_TMO])) break; if (_sp > XB_SPIN_CAP) { atomicAdd(&(bar)[XB_TMO], 1u); break; } } } } while (0)

struct XcdBarrier {
    unsigned* bar; unsigned x;
    volatile LAS unsigned* st;
};

__device__ __forceinline__ XcdBarrier xcd_barrier_post(unsigned* bar, volatile LAS unsigned* st) {
    XcdBarrier b; b.bar = bar; b.x = xb_xcc_id(); b.st = st;
    if (threadIdx.x == 0) (void)xb_add(&bar[XB_XCNT(b.x)], 1u);
    return b;
}
__device__ __forceinline__ void xcd_barrier_complete(unsigned* bar, unsigned x, unsigned& nloc, unsigned& nx) {
    const unsigned G = gridDim.x * gridDim.y * gridDim.z;
    unsigned sum, cnt, mine, sp = 0u;
    for (;;) {
        sum = 0u; cnt = 0u; mine = 0u;
#pragma unroll
        for (unsigned j = 0; j < 16; ++j) { const unsigned c = xb_ld(&bar[XB_XCNT(j)]); sum += c; cnt += (c > 0u) ? 1u : 0u; mine = (j == x) ? c : mine; }
        if (sum == G) break;
        __builtin_amdgcn_s_sleep(1);
        if ((++sp & 255u) == 0u) { if (xb_ld(&bar[XB_TMO])) break; if (sp > XB_SPIN_CAP) { atomicAdd(&bar[XB_TMO], 1u); break; } }
    }
    nloc = mine > 0u ? mine : 1u; nx = cnt > 0u ? cnt : 1u;
}

__device__ __forceinline__ void xcd_barrier(const XcdBarrier& b) {
    asm volatile("s_waitcnt vmcnt(0)" ::: "memory");
    __syncthreads();
    if (threadIdx.x == 0) {
        unsigned* bar = b.bar;
        __builtin_amdgcn_s_waitcnt(0);
        unsigned nloc = b.st[0], nx = b.st[1];
        if (nloc == 0u) { xcd_barrier_complete(bar, b.x, nloc, nx); b.st[0] = nloc; b.st[1] = nx; }
        const unsigned old = xb_add(&bar[XB_XSUB(b.x)], 1u);
        const unsigned gen = old / nloc;
        if (old + 1u == (gen + 1u) * nloc) {
            __builtin_amdgcn_fence(__ATOMIC_RELEASE, "agent");
            asm volatile("s_waitcnt vmcnt(0)" ::: "memory");
            const unsigned og = xb_add(&bar[XB_TOP], 1u);
            const unsigned tg = og / nx;
            if (og + 1u == (tg + 1u) * nx) xb_add(&bar[XB_TOPGEN], 1u);
            else XB_SPIN(xb_ld(&bar[XB_TOPGEN]) == tg, bar);
            __builtin_amdgcn_fence(__ATOMIC_ACQUIRE, "agent");
            xb_add(&bar[XB_XGEN(b.x)], 1u);
            asm volatile("s_waitcnt vmcnt(0)" ::: "memory");
        } else {
            XB_SPIN(xb_ld(&bar[XB_XGEN(b.x)]) == gen, bar);
            __builtin_amdgcn_fence(__ATOMIC_ACQUIRE, "agent");
            asm volatile("s_waitcnt vmcnt(0)" ::: "memory");
        }
    }
    __syncthreads();
}

struct Args { const float* in[27]; float* out; unsigned char* ws; int flags, pad; };


struct EpiG1 {
    static constexpr bool PERM = true, AFTER_DRAIN = false;
    bf16 *zrw, *zda, *zg;
    __device__ __forceinline__ void operator()(const f32x4 (&acc)[2][2][4][2], const pg8::Unit& u, int wr, int wc, int fr, int fq) const {
        bf16* base; int ldc, colt; float sc = 1.f; bool sg = false;
        if (u.pn < 7) { base = zrw; ldc = RW_IN; colt = u.pn * 256; }
        else if (u.pn < 13) { base = zda; ldc = DA_IN; colt = (u.pn - 7) * 256; if (u.pn < 9) sc = C2; }
        else { base = zg; ldc = GATE_IN; colt = (u.pn - 13) * 256; sg = true; }
#pragma unroll
        for (int ai = 0; ai < 2; ++ai)
#pragma unroll
            for (int m = 0; m < 4; ++m) { const int row = u.pm * 256 + ai * 128 + wr * 64 + m * 16 + fr;
#pragma unroll
                for (int bj = 0; bj < 2; ++bj) { const int col = colt + bj * 128 + wc * 32 + 8 * fq;
                    f32x4 v0 = acc[ai][bj][m][0], v1 = acc[ai][bj][m][1];
                    if (sg) {
#pragma unroll
                        for (int e = 0; e < 4; ++e) { v0[e] = sigmoidf_(v0[e]); v1[e] = sigmoidf_(v1[e]); } }
                    else { v0 = v0 * sc; v1 = v1 * sc; }
                    v4u w; w.x = pg8::cvt_pk_bf16(v0[0], v0[1]); w.y = pg8::cvt_pk_bf16(v0[2], v0[3]); w.z = pg8::cvt_pk_bf16(v1[0], v1[1]); w.w = pg8::cvt_pk_bf16(v1[2], v1[3]);
                    *(v4u*)(base + (size_t)row * ldc + col) = w; } }
    }
};
struct EpiLora {
    static constexpr bool PERM = true, AFTER_DRAIN = false;
    bf16 *dec, *av, *gv; const float *w0, *a0;
    __device__ __forceinline__ unsigned one(float v, float bias, int kind) const {
        if (kind == 0) { const float y = -(bias + v); const float sp = fmaxf(y, 0.f) + __logf(1.0f + __expf(-fabsf(y)));
            const float d = __expf(-__expf(-sp - 0.5f)); float q = rintf((d - 0.5f) * 131070.0f); q = fminf(fmaxf(q, 0.f), 65535.f); return (unsigned)q; }
        if (kind == 1) return f2bf(1.0f / (1.0f + __expf(-(bias + v))));
        return f2bf(v);
    }
    __device__ __forceinline__ void operator()(const f32x4 (&acc)[2][2][4][2], const pg8::Unit& u, int wr, int wc, int fr, int fq) const {
        const int kind = u.pn >> 1; bf16* base = dec + (size_t)kind * ((size_t)M * 512); const int colt = (u.pn & 1) * 256;
        const float* bias = kind == 0 ? w0 : a0;
#pragma unroll
        for (int bj = 0; bj < 2; ++bj) { const int col = colt + bj * 128 + wc * 32 + 8 * fq;
            f32x4 b0 = (f32x4){0.f, 0.f, 0.f, 0.f}, b1 = b0;
            if (kind < 2) { b0 = *(const f32x4*)(bias + col); b1 = *(const f32x4*)(bias + col + 4); }
#pragma unroll
            for (int ai = 0; ai < 2; ++ai)
#pragma unroll
                for (int m = 0; m < 4; ++m) { const int row = u.pm * 256 + ai * 128 + wr * 64 + m * 16 + fr;
                    const f32x4 v0 = acc[ai][bj][m][0], v1 = acc[ai][bj][m][1];
                    v4u w;
                    w.x = one(v0[0], b0[0], kind) | (one(v0[1], b0[1], kind) << 16); w.y = one(v0[2], b0[2], kind) | (one(v0[3], b0[3], kind) << 16);
                    w.z = one(v1[0], b1[0], kind) | (one(v1[1], b1[1], kind) << 16); w.w = one(v1[2], b1[2], kind) | (one(v1[3], b1[3], kind) << 16);
                    *(v4u*)(base + (size_t)row * 512 + col) = w; asm volatile("" ::: "memory"); } }
    }
};
template <int MODE> struct EpiGate {
    static constexpr bool PERM = true, AFTER_DRAIN = false;
    const bf16* sg; int goff; float* tmp; bf16* merged;
    __device__ __forceinline__ void operator()(const f32x4 (&acc)[2][2][4][2], const pg8::Unit& u, int wr, int wc, int fr, int fq) const {
#pragma unroll
        for (int ai = 0; ai < 2; ++ai)
#pragma unroll
            for (int m = 0; m < 4; ++m) { const int row = u.pm * 256 + ai * 128 + wr * 64 + m * 16 + fr;
#pragma unroll
                for (int bj = 0; bj < 2; ++bj) { const int col = u.pn * 256 + bj * 128 + wc * 32 + 8 * fq;
                    const v4u g = *(const v4u*)(sg + (size_t)row * GATE_IN + goff + col);
                    f32x4 v0 = acc[ai][bj][m][0], v1 = acc[ai][bj][m][1];
                    v0[0] *= bflo(g.x); v0[1] *= bfhi(g.x); v0[2] *= bflo(g.y); v0[3] *= bfhi(g.y);
                    v1[0] *= bflo(g.z); v1[1] *= bfhi(g.z); v1[2] *= bflo(g.w); v1[3] *= bfhi(g.w);
                    float* tp = tmp + (size_t)row * DM + col;
                    if (MODE == 0) { *(f32x4*)tp = v0; *(f32x4*)(tp + 4) = v1; }
                    else { v0 += *(const f32x4*)tp; v1 += *(const f32x4*)(tp + 4);
                        v4u w; w.x = pg8::cvt_pk_bf16(v0[0], v0[1]); w.y = pg8::cvt_pk_bf16(v0[2], v0[3]); w.z = pg8::cvt_pk_bf16(v1[0], v1[1]); w.w = pg8::cvt_pk_bf16(v1[2], v1[3]);
                        *(v4u*)(merged + (size_t)row * DM + col) = w; }
                    asm volatile("" ::: "memory"); } }
    }
};
struct EpiF32 {
    static constexpr bool PERM = true, AFTER_DRAIN = false;
    float* out; int ldc;
    __device__ __forceinline__ void operator()(const f32x4 (&acc)[2][2][4][2], const pg8::Unit& u, int wr, int wc, int fr, int fq) const {
#pragma unroll
        for (int ai = 0; ai < 2; ++ai)
#pragma unroll
            for (int m = 0; m < 4; ++m) { const int row = u.pm * 256 + ai * 128 + wr * 64 + m * 16 + fr;
#pragma unroll
                for (int bj = 0; bj < 2; ++bj) { const int col = u.pn * 256 + bj * 128 + wc * 32 + 8 * fq;
                    float* p = out + (size_t)row * ldc + col; *(f32x4*)p = acc[ai][bj][m][0]; *(f32x4*)(p + 4) = acc[ai][bj][m][1]; } }
    }
};
struct EpiRelu2 {
    static constexpr bool PERM = true, AFTER_DRAIN = false;
    bf16* out; int ldc;
    __device__ __forceinline__ void operator()(const f32x4 (&acc)[2][2][4][2], const pg8::Unit& u, int wr, int wc, int fr, int fq) const {
#pragma unroll
        for (int ai = 0; ai < 2; ++ai)
#pragma unroll
            for (int m = 0; m < 4; ++m) { const int row = u.pm * 256 + ai * 128 + wr * 64 + m * 16 + fr;
#pragma unroll
                for (int bj = 0; bj < 2; ++bj) { const int col = u.pn * 256 + bj * 128 + wc * 32 + 8 * fq;
                    f32x4 v0 = acc[ai][bj][m][0], v1 = acc[ai][bj][m][1];
#pragma unroll
                    for (int e = 0; e < 4; ++e) { const float a0 = fmaxf(v0[e], 0.f), a1 = fmaxf(v1[e], 0.f); v0[e] = a0 * a0; v1[e] = a1 * a1; }
                    v4u w; w.x = pg8::cvt_pk_bf16(v0[0], v0[1]); w.y = pg8::cvt_pk_bf16(v0[2], v0[3]); w.z = pg8::cvt_pk_bf16(v1[0], v1[1]); w.w = pg8::cvt_pk_bf16(v1[2], v1[3]);
                    *(v4u*)(out + (size_t)row * ldc + col) = w; } }
    }
};

__device__ __forceinline__ void p0_transpose_item(const float* W, int N, bf16* WT, int ldt, LAS float* scr, int item, int lane) {
    const int nblk = N / 32, kb = item / nblk, nb = item % nblk, k0 = 64 * kb, n0 = 32 * nb;
#pragma unroll 8
    for (int i = 0; i < 32; ++i) { const int kk = 2 * i + (lane >> 5); scr[kk * 33 + (lane & 31)] = W[(size_t)(k0 + kk) * N + n0 + (lane & 31)]; }
    asm volatile("s_waitcnt lgkmcnt(0)" ::: "memory");
    const int c = lane & 7;
#pragma unroll
    for (int j = 0; j < 4; ++j) { const int n = (lane >> 3) + 8 * j; const LAS float* s = scr + (8 * c) * 33 + n;
        v4u o; o.x = pk2(s[0 * 33], s[1 * 33]); o.y = pk2(s[2 * 33], s[3 * 33]); o.z = pk2(s[4 * 33], s[5 * 33]); o.w = pk2(s[6 * 33], s[7 * 33]);
        *(v4u*)(WT + (size_t)(n0 + n) * ldt + k0 + 8 * c) = o; }
    asm volatile("s_waitcnt lgkmcnt(0)" ::: "memory");
}
__device__ __forceinline__ void p0_prologue(const Args& a, LAS unsigned char* lds) {
    int tid_ = threadIdx.x; asm volatile("" : "+v"(tid_)); const int tid = tid_, lane = tid & 63, wave = tid >> 6;
    LAS float* scr = (LAS float*)(lds + wave * 16384);
    const int gw = blockIdx.x * NWAVES + wave, NGW = gridDim.x * NWAVES;
    unsigned char* ws = a.ws;
    constexpr int I_IN = (DM / 64) * (IN_W / 32), I_RW = (512 / 64) * (DM / 32), I_O = (DM / 64) * (DM / 32), I_UP = (DM / 64) * (FF / 32), I_DN = (FF / 64) * (DM / 32);
    constexpr int I_L2 = 512 / 32, I_G2 = 2 * (512 / 32);
    constexpr int NITEMS = I_IN + 2 * I_RW + I_O + I_UP + I_DN + 2 * I_L2 + I_G2;
    for (int it = gw; it < NITEMS; it += NGW) {
        int r = it;
        if (r < I_IN) { p0_transpose_item(a.in[2], IN_W, (bf16*)(ws + WS_WIN), DM, scr, r, lane); continue; } r -= I_IN;
        if (r < I_RW) { p0_transpose_item(a.in[14], DM, (bf16*)(ws + WS_WRW), 512, scr, r, lane); continue; } r -= I_RW;
        if (r < I_RW) { p0_transpose_item(a.in[20], DM, (bf16*)(ws + WS_WDA), 512, scr, r, lane); continue; } r -= I_RW;
        if (r < I_O) { p0_transpose_item(a.in[21], DM, (bf16*)(ws + WS_WO), DM, scr, r, lane); continue; } r -= I_O;
        if (r < I_UP) { p0_transpose_item(a.in[24], FF, (bf16*)(ws + WS_WUP), DM, scr, r, lane); continue; } r -= I_UP;
        if (r < I_DN) { p0_transpose_item(a.in[25], DM, (bf16*)(ws + WS_WDN), FF, scr, r, lane); continue; } r -= I_DN;
        if (r < I_L2) { p0_transpose_item(a.in[5], 512, (bf16*)(ws + WS_LORA), 256, scr, r, lane); continue; } r -= I_L2;
        if (r < I_L2) { p0_transpose_item(a.in[7], 512, (bf16*)(ws + WS_LORA) + 512 * 256 + 64, 256, scr, r, lane); continue; } r -= I_L2;
        p0_transpose_item(a.in[8], 512, (bf16*)(ws + WS_LORA) + 1024 * 256 + 128, 256, scr, r, lane);
    }
    for (int ch = blockIdx.x * NTHR + tid; ch < 1536 * 32; ch += gridDim.x * NTHR) {
        const int n = ch >> 5, k0 = (ch & 31) * 8; const int kind = n >> 9;
        const bool nz = (kind == 0) ? (k0 < 64) : (kind == 1 ? (k0 >= 64 && k0 < 128) : (k0 >= 128));
        if (!nz) *(v4u*)((bf16*)(ws + WS_LORA) + (size_t)n * 256 + k0) = (v4u){0u, 0u, 0u, 0u};
    }
    const float* g = a.in[1];
    f32x4 gv[4];
#pragma unroll
    for (int j = 0; j < 4; ++j) gv[j] = *(const f32x4*)(g + 4 * lane + 256 * j);
    for (int m = gw; m < M; m += NGW) {
        const f32x4* xr = (const f32x4*)(a.in[0] + (size_t)m * DM) + lane;
        f32x4 v[4]; float s = 0.f;
#pragma unroll
        for (int j = 0; j < 4; ++j) { v[j] = xr[64 * j]; s += (v[j].x * v[j].x + v[j].y * v[j].y) + (v[j].z * v[j].z + v[j].w * v[j].w); }
        const float rs = 1.0f / sqrtf(wave_sum(s) * (1.f / DM) + 1e-6f);
        v2u* o8 = (v2u*)((bf16*)(ws + WS_XN) + (size_t)m * DM) + lane;
#pragma unroll
        for (int j = 0; j < 4; ++j) { v2u w; w.x = pk2(v[j].x * rs * gv[j].x, v[j].y * rs * gv[j].y); w.y = pk2(v[j].z * rs * gv[j].z, v[j].w * rs * gv[j].w); o8[64 * j] = w; }
    }
}

__device__ __forceinline__ void prep_a(const Args& a) {
    int tid_ = threadIdx.x; asm volatile("" : "+v"(tid_)); const int tid = tid_, lane = tid & 63, wave = tid >> 6;
    const int gw = blockIdx.x * NWAVES + wave, NGW = gridDim.x * NWAVES;
    const bf16* zrw = (const bf16*)(a.ws + WS_ZRW); bf16* T = (bf16*)(a.ws + WS_XN);
    const int c = 4 * lane; const f32x4 mu = *(const f32x4*)(a.in[3] + 1536 + c);
    for (int t = gw; t < M; t += NGW) {
        const v2u cur = *(const v2u*)(zrw + (size_t)t * RW_IN + 1536 + c);
        v2u prv = (v2u){0u, 0u}; if ((t & (SEQ - 1)) != 0) prv = *(const v2u*)(zrw + (size_t)(t - 1) * RW_IN + 1536 + c);
        float u[4]; const float zc[4] = {bflo(cur.x), bfhi(cur.x), bflo(cur.y), bfhi(cur.y)}, zp[4] = {bflo(prv.x), bfhi(prv.x), bflo(prv.y), bfhi(prv.y)};
#pragma unroll
        for (int e = 0; e < 4; ++e) { const float x = zc[e] + (zp[e] - zc[e]) * mu[e];
            u[e] = (c < 64) ? tanhf(x) : ((c < 128) ? x : 1.0f / (1.0f + expf(-x))); }
        v2u w; w.x = pk2(u[0], u[1]); w.y = pk2(u[2], u[3]);
        *(v2u*)(T + (size_t)t * 256 + c) = w;
    }
}

__device__ __forceinline__ float lerp_col(const bf16* zrw, int t, int col, float mu) {
    const float zc = bf2f(zrw[(size_t)t * RW_IN + col]);
    const float zp = ((t & (SEQ - 1)) != 0) ? bf2f(zrw[(size_t)(t - 1) * RW_IN + col]) : 0.f;
    return zc + (zp - zc) * mu;
}

__device__ __forceinline__ void scan_naive(const Args& a, LAS unsigned char* lds) {
    int tid_ = threadIdx.x; asm volatile("" : "+v"(tid_)); const int tid = tid_, lane = tid & 63, h = tid >> 6; const int b = blockIdx.x;
    const bf16* zrw = (const bf16*)(a.ws + WS_ZRW);
    const bf16* DEC = (const bf16*)((unsigned char*)a.out + DO_DEC); const bf16* AV = (const bf16*)((unsigned char*)a.out + DO_A);
    bf16* YR = (bf16*)((unsigned char*)a.out + DO_YRAW);
    LAS float* L = (LAS float*)lds + h * 320;
    const int col = h * 64 + lane;
    const float mu_r = a.in[3][col], mu_k = a.in[3][512 + col], mu_v = a.in[3][1024 + col];
    const float kkc = a.in[9][col], kac = a.in[10][col];
    float S[64];
#pragma unroll
    for (int j = 0; j < 64; ++j) S[j] = 0.f;
    for (int tt = 0; tt < SEQ; ++tt) {
        const int t = b * SEQ + tt;
        const float r = lerp_col(zrw, t, col, mu_r), k = lerp_col(zrw, t, 512 + col, mu_k), v = lerp_col(zrw, t, 1024 + col, mu_v);
        const float dec = 0.5f + (float)DEC[(size_t)t * 512 + col] * (1.0f / 131070.0f);
        const float av = bf2f(AV[(size_t)t * 512 + col]);
        const float kkr = k * kkc; const float n2 = wave_sum(kkr * kkr); const float kk = kkr / fmaxf(sqrtf(n2), 1e-12f);
        const float kp = k * (1.0f + (av - 1.0f) * kac);
        __syncthreads();
        L[lane] = dec; L[64 + lane] = kk; L[128 + lane] = kk * av; L[192 + lane] = kp; L[256 + lane] = r;
        __syncthreads();
        float sa = 0.f;
#pragma unroll
        for (int j = 0; j < 64; j += 4) { const f32x4 q = *(const LAS f32x4*)(L + 64 + j); sa += S[j] * q[0] + S[j + 1] * q[1] + S[j + 2] * q[2] + S[j + 3] * q[3]; asm volatile("" ::: "memory"); }
        sa = -sa; float y = 0.f;
#pragma unroll
        for (int j = 0; j < 64; j += 4) { const f32x4 w = *(const LAS f32x4*)(L + j), bb = *(const LAS f32x4*)(L + 128 + j), kq = *(const LAS f32x4*)(L + 192 + j), rq = *(const LAS f32x4*)(L + 256 + j);
#pragma unroll
            for (int e = 0; e < 4; ++e) { S[j + e] = S[j + e] * w[e] + sa * bb[e] + v * kq[e]; y += S[j + e] * rq[e]; }
            asm volatile("" ::: "memory"); }
        YR[(size_t)t * 512 + col] = (bf16)f2bf(y);
    }
}

__device__ __forceinline__ float block_max(float v, LAS float* red, int tid) {
    v = wave_max(v); __syncthreads(); if ((tid & 63) == 0) red[tid >> 6] = v; __syncthreads();
    float r = red[0];
#pragma unroll
    for (int i = 1; i < 8; ++i) r = fmaxf(r, red[i]);
    return r;
}
__device__ __forceinline__ float block_sum(float v, LAS float* red, int tid) {
    v = wave_sum(v); __syncthreads(); if ((tid & 63) == 0) red[tid >> 6] = v; __syncthreads();
    float r = red[0];
#pragma unroll
    for (int i = 1; i < 8; ++i) r += red[i];
    return r;
}
__device__ __forceinline__ void attn_naive(const Args& a, LAS unsigned char* lds, int first_blk) {
    int tid_ = threadIdx.x; asm volatile("" : "+v"(tid_)); const int tid = tid_;
    LAS float* sc = (LAS float*)lds;
    LAS float* red = (LAS float*)(lds + 65536);
    LAS float* op = (LAS float*)(lds + 65536 + 256);
    const bf16* zda = (const bf16*)(a.ws + WS_ZDA); bf16* dao = (bf16*)(a.ws + WS_DAO);
    float lam; { float s1 = 0.f, s2 = 0.f;
#pragma unroll 1
        for (int i = 0; i < 64; ++i) { s1 += a.in[15][i] * a.in[16][i]; s2 += a.in[17][i] * a.in[18][i]; } lam = expf(s1) - expf(s2) + LAMBDA_INIT; }
    const int nb = gridDim.x - first_blk;
    for (int unit = blockIdx.x - first_blk; unit < BATCH * 4 * SEQ; unit += nb) {
        const int t = unit & (SEQ - 1), h = (unit >> 13) & 3, b = unit >> 15;
        const size_t rowb = (size_t)b * SEQ; const int kend = ((t >> 6) + 1) << 6;
        float lsum[2];
#pragma unroll
        for (int m = 0; m < 2; ++m) {
            LAS float* qs = (LAS float*)(lds + 65536 + 8192);
            __syncthreads();
            if (tid < 64) qs[tid] = bf2f(zda[(rowb + t) * DA_IN + (h * 2 + m) * 64 + tid]);
            __syncthreads();
            float lmax = -INFINITY;
#pragma unroll 1
            for (int key = tid; key < kend; key += NTHR) {
                const v4u* kp = (const v4u*)(zda + (rowb + key) * DA_IN + 512 + (h * 2 + m) * 64); float s = 0.f;
#pragma unroll
                for (int c = 0; c < 8; ++c) { const v4u w = kp[c]; const f32x4 qa = *(const LAS f32x4*)(qs + 8 * c), qb = *(const LAS f32x4*)(qs + 8 * c + 4);
                    s += qa[0] * bflo(w.x) + qa[1] * bfhi(w.x) + qa[2] * bflo(w.y) + qa[3] * bfhi(w.y) + qb[0] * bflo(w.z) + qb[1] * bfhi(w.z) + qb[2] * bflo(w.w) + qb[3] * bfhi(w.w); }
                sc[m * SEQ + key] = s; lmax = fmaxf(lmax, s);
            }
            const float mx = block_max(lmax, red, tid);
            float ls = 0.f;
#pragma unroll 1
            for (int key = tid; key < kend; key += NTHR) { const float p = exp2f(sc[m * SEQ + key] - mx); sc[m * SEQ + key] = p; ls += p; }
            lsum[m] = block_sum(ls, red, tid);
        }
        __syncthreads();
        const int d = tid & 127, part = tid >> 7; float o1 = 0.f, o2 = 0.f;
        const bf16* vp = zda + rowb * DA_IN + 1024 + h * 128 + d;
#pragma unroll 2
        for (int key = part; key < kend; key += 4) { const float v = bf2f(vp[(size_t)key * DA_IN]); o1 += sc[key] * v; o2 += sc[SEQ + key] * v; }
        op[(part * 2 + 0) * 128 + d] = o1; op[(part * 2 + 1) * 128 + d] = o2;
        __syncthreads();
        float o = 0.f;
        if (tid < 128) { const float O1 = (op[d] + op[256 + d] + op[512 + d] + op[768 + d]) / lsum[0], O2 = (op[128 + d] + op[384 + d] + op[640 + d] + op[896 + d]) / lsum[1]; o = O1 - lam * O2; }
        const float ss = block_sum(o * o, red, tid);
        if (tid < 128) dao[(rowb + t) * 512 + h * 128 + d] = (bf16)f2bf(o * (1.0f / sqrtf(ss * (1.0f / 128.0f) + 1e-5f)) * a.in[19][d] * (1.0f - LAMBDA_INIT));
        __syncthreads();
    }
}

typedef float f32x2 __attribute__((ext_vector_type(2)));
template <int CTRL> __device__ __forceinline__ float dppf(float x) { return __int_as_float(__builtin_amdgcn_update_dpp(0, __float_as_int(x), CTRL, 0xF, 0xF, false)); }
__device__ __forceinline__ float row16_sum(float x) { x += dppf<0xB1>(x); x += dppf<0x4E>(x); x += dppf<0x141>(x); x += dppf<0x140>(x); return x; }
constexpr int SC_TC = 32, SC_REC = 336, SC_NCH = SEQ / SC_TC;
__device__ __forceinline__ float ysum16(const LAS float* p) { const f32x4 a = *(const LAS f32x4*)p, b = *(const LAS f32x4*)(p + 4), c = *(const LAS f32x4*)(p + 8), d = *(const LAS f32x4*)(p + 12);
    const f32x4 s = (a + b) + (c + d); return (s[0] + s[1]) + (s[2] + s[3]); }
constexpr int SCAN_BLOCKS = 128;
#define SC_BAR() asm volatile("s_waitcnt lgkmcnt(0)\n\ts_barrier" ::: "memory")
__device__ __forceinline__ void scan_fast(const Args& a, LAS unsigned char* lds) {
    int tid_ = threadIdx.x; asm volatile("" : "+v"(tid_)); const int tid = tid_, lane = tid & 63; const int wave = __builtin_amdgcn_readfirstlane(tid >> 6);
    const int c = blockIdx.x, b = c >> 6, h = (c >> 3) & 7, i0 = 8 * (c & 7);
    const int jl = lane & 15, ts = lane >> 4;
    const bf16* zrw = (const bf16*)(a.ws + WS_ZRW) + (size_t)b * SEQ * RW_IN;
    const bf16* DEC = (const bf16*)((unsigned char*)a.out + DO_DEC) + (size_t)b * SEQ * 512;
    const bf16* AV = (const bf16*)((unsigned char*)a.out + DO_A) + (size_t)b * SEQ * 512;
    bf16* YR = (bf16*)((unsigned char*)a.out + DO_YRAW) + (size_t)b * SEQ * 512;
    LAS float* ybuf = (LAS float*)lds;
    LAS float* buf = (LAS float*)(lds + 32768);
    if ((wave & 2) != 0) {
        const int pw = (wave & 1) | ((wave >> 2) << 1), cj = h * 64 + 4 * jl, cv = 1024 + h * 64 + i0 + (jl & 7);
        const f32x4 mu_r = *(const f32x4*)(a.in[3] + cj), mu_k = *(const f32x4*)(a.in[3] + 512 + cj); const float mu_v = a.in[3][cv];
        const f32x4 kkc = *(const f32x4*)(a.in[9] + cj), kac = *(const f32x4*)(a.in[10] + cj);
        v2u zr_c[2][2], zr_p[2][2], zk_c[2][2], zk_p[2][2], dd[2][2], aa[2][2]; unsigned zv_c[2][2], zv_p[2][2];
        const int fp = pw * 64 + lane, ftt = fp >> 3, fr = fp & 7;
        bf16* yfl = YR + (size_t)ftt * 512 + h * 64 + i0 + fr;
#define SC_ISSUE(S, ch) do { _Pragma("unroll") for (int q = 0; q < 2; ++q) { const int t = (ch) * SC_TC + 4 * (pw * 2 + q) + ts; \
            const bf16* zc = zrw + (size_t)t * RW_IN; const bf16* zp = zc - (t > 0 ? RW_IN : 0); \
            zr_c[S][q] = *(const v2u*)(zc + cj); zk_c[S][q] = *(const v2u*)(zc + 512 + cj); zv_c[S][q] = zc[cv]; \
            zr_p[S][q] = *(const v2u*)(zp + cj); zk_p[S][q] = *(const v2u*)(zp + 512 + cj); zv_p[S][q] = zp[cv]; \
            dd[S][q] = *(const v2u*)(DEC + (size_t)t * 512 + cj); aa[S][q] = *(const v2u*)(AV + (size_t)t * 512 + cj); } } while (0)
#define SC_WRITE(S, ch) do { _Pragma("unroll") for (int q = 0; q < 2; ++q) { const int tt = 4 * (pw * 2 + q) + ts; const bool first = ((ch) * SC_TC + tt) == 0; \
            LAS float* rec = buf + ((ch) & 1) * (SC_TC * SC_REC) + tt * SC_REC; \
            const float rc[4] = {bflo(zr_c[S][q].x), bfhi(zr_c[S][q].x), bflo(zr_c[S][q].y), bfhi(zr_c[S][q].y)}, rp[4] = {bflo(zr_p[S][q].x), bfhi(zr_p[S][q].x), bflo(zr_p[S][q].y), bfhi(zr_p[S][q].y)}; \
            const float kc[4] = {bflo(zk_c[S][q].x), bfhi(zk_c[S][q].x), bflo(zk_c[S][q].y), bfhi(zk_c[S][q].y)}, kp_[4] = {bflo(zk_p[S][q].x), bfhi(zk_p[S][q].x), bflo(zk_p[S][q].y), bfhi(zk_p[S][q].y)}; \
            const float av[4] = {bflo(aa[S][q].x), bfhi(aa[S][q].x), bflo(aa[S][q].y), bfhi(aa[S][q].y)}; \
            const float dc[4] = {(float)(dd[S][q].x & 0xffffu), (float)(dd[S][q].x >> 16), (float)(dd[S][q].y & 0xffffu), (float)(dd[S][q].y >> 16)}; \
            f32x4 R4, K4, W4, KK4, B4; float n2 = 0.f; \
            _Pragma("unroll") for (int e = 0; e < 4; ++e) { const float pr = first ? 0.f : rp[e], pk = first ? 0.f : kp_[e]; \
                const float r = rc[e] + (pr - rc[e]) * mu_r[e], k = kc[e] + (pk - kc[e]) * mu_k[e]; \
                R4[e] = r; W4[e] = 0.5f + dc[e] * (1.0f / 131070.0f); const float kkr = k * kkc[e]; KK4[e] = kkr; n2 += kkr * kkr; \
                K4[e] = k * (1.0f + (av[e] - 1.0f) * kac[e]); } \
            n2 = row16_sum(n2); const float invn = fminf(__builtin_amdgcn_rsqf(n2), 1e12f);     \
            _Pragma("unroll") for (int e = 0; e < 4; ++e) { KK4[e] *= invn; B4[e] = -KK4[e] * av[e]; } \
            const float vc = bf2f(zv_c[S][q]), vp = first ? 0.f : bf2f(zv_p[S][q]); \
            f32x4 WK4; float c1 = 0.f, c2 = 0.f; \
            _Pragma("unroll") for (int e = 0; e < 4; ++e) { const float kn = __shfl_down(KK4[e], 16); WK4[e] = W4[e] * kn; c1 += B4[e] * kn; c2 += K4[e] * kn; }     \
            c1 = row16_sum(c1); c2 = row16_sum(c2); \
            *(LAS f32x4*)(rec + 4 * jl) = W4; *(LAS f32x4*)(rec + 128 + 4 * jl) = B4; *(LAS f32x4*)(rec + 192 + 4 * jl) = K4; *(LAS f32x4*)(rec + 256 + 4 * jl) = R4; \
            if (!(ts & 1)) { *(LAS f32x4*)(rec + 64 + 4 * jl) = KK4; *(LAS f32x4*)(rec + SC_REC + 64 + 4 * jl) = WK4; if (jl == 0) { rec[328] = c1; rec[329] = c2; } }     \
            if (jl < 8) rec[320 + jl] = vc + (vp - vc) * mu_v; } } while (0)
        SC_ISSUE(0, 0); SC_WRITE(0, 0); SC_ISSUE(0, 1); SC_ISSUE(1, 2);
        SC_BAR();
#pragma unroll 1
        for (int ch = 0; ch < SC_NCH; ch += 2) {
            SC_WRITE(0, ch + 1);
            if (ch + 3 < SC_NCH) SC_ISSUE(0, ch + 3);
            if (ch > 0) yfl[(size_t)(ch - 1) * SC_TC * 512] = (bf16)f2bf(ysum16(ybuf + ((ch - 1) & 1) * 4096 + fp * 16));
            SC_BAR();
            if (ch + 2 < SC_NCH) SC_WRITE(1, ch + 2);
            if (ch + 4 < SC_NCH) SC_ISSUE(1, ch + 4);
            yfl[(size_t)ch * SC_TC * 512] = (bf16)f2bf(ysum16(ybuf + (ch & 1) * 4096 + fp * 16));
            SC_BAR();
        }
        yfl[(size_t)(SC_NCH - 1) * SC_TC * 512] = (bf16)f2bf(ysum16(ybuf + ((SC_NCH - 1) & 1) * 4096 + fp * 16));
#undef SC_ISSUE
#undef SC_WRITE
    } else if (wave < 2) {
        const int rowl = 4 * wave + ts;
        f32x2 S01 = (f32x2){0.f, 0.f}, S23 = (f32x2){0.f, 0.f};
        SC_BAR();
#pragma unroll 1
        for (int ch = 0; ch < SC_NCH; ++ch) {
            const LAS float* cb = buf + (ch & 1) * (SC_TC * SC_REC);
            LAS float* yb = ybuf + (ch & 1) * 4096 + rowl * 16 + jl;
#define SC_LOAD(P, r0) do { P##W0 = *(const LAS f32x4*)((r0) + 4 * jl); P##KK0 = *(const LAS f32x4*)((r0) + 64 + 4 * jl); P##B0 = *(const LAS f32x4*)((r0) + 128 + 4 * jl); \
                P##K0 = *(const LAS f32x4*)((r0) + 192 + 4 * jl); P##R0 = *(const LAS f32x4*)((r0) + 256 + 4 * jl); \
                P##W1 = *(const LAS f32x4*)((r0) + SC_REC + 4 * jl); P##WK = *(const LAS f32x4*)((r0) + SC_REC + 64 + 4 * jl); P##B1 = *(const LAS f32x4*)((r0) + SC_REC + 128 + 4 * jl); \
                P##K1 = *(const LAS f32x4*)((r0) + SC_REC + 192 + 4 * jl); P##R1 = *(const LAS f32x4*)((r0) + SC_REC + 256 + 4 * jl); \
                P##v0 = (r0)[320 + rowl]; P##v1 = (r0)[SC_REC + 320 + rowl]; { const f32x2 cc_ = *(const LAS f32x2*)((r0) + 328); P##c1 = cc_.x; P##c2 = cc_.y; } } while (0)
#define LO2(x) ((f32x2){(x)[0], (x)[1]})
#define HI2(x) ((f32x2){(x)[2], (x)[3]})
            f32x4 aW0, aKK0, aB0, aK0, aR0, aW1, aWK, aB1, aK1, aR1; float av0, av1, ac1, ac2;
            SC_LOAD(a, cb);
#pragma unroll 4
            for (int pp = 0; pp < SC_TC / 2; ++pp) {
                const LAS float* rn = cb + (pp + 1 < SC_TC / 2 ? pp + 1 : pp) * (2 * SC_REC);
                f32x4 nW0, nKK0, nB0, nK0, nR0, nW1, nWK, nB1, nK1, nR1; float nv0, nv1, nc1, nc2;
                SC_LOAD(n, rn);
                f32x2 p = S01 * LO2(aKK0); p = S23 * HI2(aKK0) + p;
                f32x2 q = S01 * LO2(aWK); q = S23 * HI2(aWK) + q;
                float d0 = p.x + p.y, e0 = q.x + q.y;
                d0 = row16_sum(d0); e0 = row16_sum(e0);
                const float d1 = d0 * ac1 + (e0 + av0 * ac2);
                const f32x2 v0v = (f32x2){av0, av0}, v1v = (f32x2){av1, av1}, d0v = (f32x2){d0, d0}, d1v = (f32x2){d1, d1};
                f32x2 u01 = LO2(aK0) * v0v, u23 = HI2(aK0) * v0v;
                u01 = S01 * LO2(aW0) + u01; u23 = S23 * HI2(aW0) + u23;
                S01 = LO2(aB0) * d0v + u01; S23 = HI2(aB0) * d0v + u23;
                f32x2 y0 = S01 * LO2(aR0); y0 = S23 * HI2(aR0) + y0;
                yb[(2 * pp) * 128] = y0.x + y0.y;
                f32x2 w01 = LO2(aK1) * v1v, w23 = HI2(aK1) * v1v;
                w01 = S01 * LO2(aW1) + w01; w23 = S23 * HI2(aW1) + w23;
                S01 = LO2(aB1) * d1v + w01; S23 = HI2(aB1) * d1v + w23;
                f32x2 y1 = S01 * LO2(aR1); y1 = S23 * HI2(aR1) + y1;
                yb[(2 * pp + 1) * 128] = y1.x + y1.y;
                aW0 = nW0; aKK0 = nKK0; aB0 = nB0; aK0 = nK0; aR0 = nR0; aW1 = nW1; aWK = nWK; aB1 = nB1; aK1 = nK1; aR1 = nR1; av0 = nv0; av1 = nv1; ac1 = nc1; ac2 = nc2;
            }
#undef SC_LOAD
#undef LO2
#undef HI2
            SC_BAR();
        }
    } else {
        SC_BAR();
#pragma unroll 1
        for (int ch = 0; ch < SC_NCH; ++ch) SC_BAR();
    }
}

__device__ __forceinline__ void attn_static(const Args& a, unsigned char* lds_generic) {
    const int G = gridDim.x, bx = blockIdx.x; const int vcu = (G % 8 == 0) ? (bx % 8) * (G / 8) + bx / 8 : bx;
    const attn_body::bf16* zda = (const attn_body::bf16*)(a.ws + WS_ZDA); attn_body::bf16* O = (attn_body::bf16*)(a.ws + WS_XN);
    for (int v = vcu; v < 256; v += G) {
        const int bh = v >> 3, s = v & 7;
#pragma unroll 1
        for (int i = 0; i < 4; ++i) { const int qb = (i == 0) ? s : (i == 1) ? 15 - s : (i == 2) ? 16 + s : 31 - s;
            attn_body::attn_unit_vh<8>(bh >> 4, bh & 15, qb, zda, O, (char*)lds_generic); }
    }
}
__device__ __forceinline__ void unpack8(const v4u w, float (&o)[8]) { o[0] = bflo(w.x); o[1] = bfhi(w.x); o[2] = bflo(w.y); o[3] = bfhi(w.y); o[4] = bflo(w.z); o[5] = bfhi(w.z); o[6] = bflo(w.w); o[7] = bfhi(w.w); }
__device__ __forceinline__ float oct_sum(float x) { x += dppf<0xB1>(x); x += dppf<0x4E>(x); x += dppf<0x141>(x); return x; }
__device__ __forceinline__ void attn_queue(const Args& a, unsigned char* lds_generic, LAS unsigned char* lds) {
    const attn_body::bf16* zda = (const attn_body::bf16*)(a.ws + WS_ZDA); attn_body::bf16* O = (attn_body::bf16*)(a.ws + WS_XN);
    unsigned* ctr = (unsigned*)(a.ws + WS_CTL);
    volatile LAS unsigned* slot = (volatile LAS unsigned*)(lds + 135168);
    for (;;) {
        __syncthreads();
        if (threadIdx.x == 0) *slot = __hip_atomic_fetch_add(ctr, 1u, __ATOMIC_RELAXED, __HIP_MEMORY_SCOPE_AGENT);
        __syncthreads();
        const unsigned u = __builtin_amdgcn_readfirstlane(*slot);
        if (u >= 1024u) break;
        const int qb = 31 - (int)(u >> 5), bvh = (int)(u & 31);
        attn_body::attn_unit_vh<8>(bvh >> 4, bvh & 15, qb, zda, O, (char*)lds_generic);
    }
}
__device__ __forceinline__ void post_da(const Args& a) {
    int tid_ = threadIdx.x; asm volatile("" : "+v"(tid_)); const int tid = tid_, lane = tid & 63, wave = tid >> 6;
    const int gw = blockIdx.x * NWAVES + wave, NGW = gridDim.x * NWAVES;
    const bf16* O = (const bf16*)(a.ws + WS_XN); bf16* dao = (bf16*)(a.ws + WS_DAO);
    float lam; { float s1 = 0.f, s2 = 0.f;
#pragma unroll 1
        for (int i = 0; i < 64; ++i) { s1 += a.in[15][i] * a.in[16][i]; s2 += a.in[17][i] * a.in[18][i]; } lam = expf(s1) - expf(s2) + LAMBDA_INIT; }
    const int h = lane >> 4, d0 = 8 * (lane & 15);
    float sg[8];
#pragma unroll
    for (int e = 0; e < 8; ++e) sg[e] = a.in[19][d0 + e] * (1.0f - LAMBDA_INIT);
#pragma unroll 2
    for (int t = gw; t < M; t += NGW) {
        const v4u w1 = *(const v4u*)(O + (size_t)t * 1024 + h * 256 + d0), w2 = *(const v4u*)(O + (size_t)t * 1024 + h * 256 + 128 + d0);
        float o1[8], o2[8]; unpack8(w1, o1); unpack8(w2, o2); float ss = 0.f;
#pragma unroll
        for (int e = 0; e < 8; ++e) { o1[e] -= lam * o2[e]; ss += o1[e] * o1[e]; }
        const float rs = 1.0f / sqrtf(row16_sum(ss) * (1.0f / 128.0f) + 1e-5f);
        v4u w; w.x = pk2(o1[0] * rs * sg[0], o1[1] * rs * sg[1]); w.y = pk2(o1[2] * rs * sg[2], o1[3] * rs * sg[3]); w.z = pk2(o1[4] * rs * sg[4], o1[5] * rs * sg[5]); w.w = pk2(o1[6] * rs * sg[6], o1[7] * rs * sg[7]);
        *(v4u*)(dao + (size_t)t * 512 + h * 128 + d0) = w;
    }
}

__device__ __forceinline__ void post_rw(const Args& a) {
    int tid_ = threadIdx.x; asm volatile("" : "+v"(tid_)); const int tid = tid_, lane = tid & 63, wave = tid >> 6;
    const int gw = blockIdx.x * NWAVES + wave, NGW = gridDim.x * NWAVES;
    const bf16* zrw = (const bf16*)(a.ws + WS_ZRW);
    const bf16* AV = (const bf16*)((unsigned char*)a.out + DO_A); const bf16* GV = (const bf16*)((unsigned char*)a.out + DO_G);
    const bf16* YR = (const bf16*)((unsigned char*)a.out + DO_YRAW); bf16* RWO = (bf16*)((unsigned char*)a.out + DO_RWO);
    const int col = 8 * lane;
    float mur[8], muk[8], muv[8], kac[8], rkc[8], gng[8], gnb[8];
#pragma unroll
    for (int e = 0; e < 8; ++e) { mur[e] = a.in[3][col + e]; muk[e] = a.in[3][512 + col + e]; muv[e] = a.in[3][1024 + col + e]; kac[e] = a.in[10][col + e]; rkc[e] = a.in[11][col + e]; gng[e] = a.in[12][col + e]; gnb[e] = a.in[13][col + e]; }
#pragma unroll 2
    for (int t = gw; t < M; t += NGW) {
        const bf16* zc = zrw + (size_t)t * RW_IN + col; const bool first = (t & (SEQ - 1)) == 0; const bf16* zp = zc - (first ? 0 : RW_IN);
        const v4u wy = *(const v4u*)(YR + (size_t)t * 512 + col), wa = *(const v4u*)(AV + (size_t)t * 512 + col), wg = *(const v4u*)(GV + (size_t)t * 512 + col);
        const v4u wrc = *(const v4u*)zc, wkc = *(const v4u*)(zc + 512), wvc = *(const v4u*)(zc + 1024), wrp = *(const v4u*)zp, wkp = *(const v4u*)(zp + 512), wvp = *(const v4u*)(zp + 1024);
        float y[8], av[8], g[8], rc[8], kc[8], vc[8], rp[8], kp[8], vp[8];
        unpack8(wy, y); unpack8(wa, av); unpack8(wg, g); unpack8(wrc, rc); unpack8(wkc, kc); unpack8(wvc, vc); unpack8(wrp, rp); unpack8(wkp, kp); unpack8(wvp, vp);
        float s = 0.f, rk = 0.f;
#pragma unroll
        for (int e = 0; e < 8; ++e) { s += y[e];
            const float pr = first ? 0.f : rp[e], pk = first ? 0.f : kp[e], pv = first ? 0.f : vp[e];
            const float r = rc[e] + (pr - rc[e]) * mur[e], k = kc[e] + (pk - kc[e]) * muk[e]; vc[e] = vc[e] + (pv - vc[e]) * muv[e];
            rk += r * (k * (1.0f + (av[e] - 1.0f) * kac[e])) * rkc[e]; }
        const float mean = oct_sum(s) * (1.f / 64.f); rk = oct_sum(rk); float q = 0.f;
#pragma unroll
        for (int e = 0; e < 8; ++e) { y[e] -= mean; q += y[e] * y[e]; }
        const float rstd = 1.0f / sqrtf(oct_sum(q) * (1.f / 64.f) + 64e-5f);
        float o[8];
#pragma unroll
        for (int e = 0; e < 8; ++e) o[e] = (y[e] * rstd * gng[e] + gnb[e] + rk * vc[e]) * g[e];
        v4u w; w.x = pk2(o[0], o[1]); w.y = pk2(o[2], o[3]); w.z = pk2(o[4], o[5]); w.w = pk2(o[6], o[7]);
        *(v4u*)(RWO + (size_t)t * 512 + col) = w;
    }
}

__device__ __forceinline__ void rows1(const Args& a) {
    int tid_ = threadIdx.x; asm volatile("" : "+v"(tid_)); const int tid = tid_, lane = tid & 63, wave = tid >> 6;
    const int gw = blockIdx.x * NWAVES + wave, NGW = gridDim.x * NWAVES;
    const float* Y = (const float*)(a.ws + WS_Y); bf16* H2 = (bf16*)(a.ws + WS_XN);
    f32x4 g1[4], g2[4];
#pragma unroll
    for (int j = 0; j < 4; ++j) { g1[j] = *(const f32x4*)(a.in[22] + 4 * lane + 256 * j); g2[j] = *(const f32x4*)(a.in[23] + 4 * lane + 256 * j); }
#pragma unroll 2
    for (int m = gw; m < M; m += NGW) {
        const f32x4* yr = (const f32x4*)(Y + (size_t)m * DM) + lane; const f32x4* xr = (const f32x4*)(a.in[0] + (size_t)m * DM) + lane;
        f32x4 v[4]; float s = 0.f;
#pragma unroll
        for (int j = 0; j < 4; ++j) { v[j] = yr[64 * j]; s += (v[j].x * v[j].x + v[j].y * v[j].y) + (v[j].z * v[j].z + v[j].w * v[j].w); }
        const float rs = 1.0f / sqrtf(wave_sum(s) * (1.f / DM) + 1e-6f); float s2 = 0.f;
#pragma unroll
        for (int j = 0; j < 4; ++j) { const f32x4 g = g1[j]; v[j] = xr[64 * j] + v[j] * rs * g; s2 += (v[j].x * v[j].x + v[j].y * v[j].y) + (v[j].z * v[j].z + v[j].w * v[j].w); }
        const float rs2 = 1.0f / sqrtf(wave_sum(s2) * (1.f / DM) + 1e-6f);
        f32x4* orow = (f32x4*)(a.out + (size_t)m * DM) + lane; v2u* h8 = (v2u*)(H2 + (size_t)m * DM) + lane;
#pragma unroll
        for (int j = 0; j < 4; ++j) { orow[64 * j] = v[j]; const f32x4 g = g2[j];
            v2u w; w.x = pk2(v[j].x * rs2 * g.x, v[j].y * rs2 * g.y); w.y = pk2(v[j].z * rs2 * g.z, v[j].w * rs2 * g.w); h8[64 * j] = w; }
    }
}
__device__ __forceinline__ void rows2(const Args& a) {
    int tid_ = threadIdx.x; asm volatile("" : "+v"(tid_)); const int tid = tid_, lane = tid & 63, wave = tid >> 6;
    const int gw = blockIdx.x * NWAVES + wave, NGW = gridDim.x * NWAVES;
    const float* F = (const float*)(a.ws + WS_F);
    f32x4 g3[4];
#pragma unroll
    for (int j = 0; j < 4; ++j) g3[j] = *(const f32x4*)(a.in[26] + 4 * lane + 256 * j);
#pragma unroll 2
    for (int m = gw; m < M; m += NGW) {
        const f32x4* fr = (const f32x4*)(F + (size_t)m * DM) + lane; f32x4* orow = (f32x4*)(a.out + (size_t)m * DM) + lane;
        f32x4 v[4], xo[4]; float s = 0.f;
#pragma unroll
        for (int j = 0; j < 4; ++j) xo[j] = orow[64 * j];
#pragma unroll
        for (int j = 0; j < 4; ++j) { v[j] = fr[64 * j]; s += (v[j].x * v[j].x + v[j].y * v[j].y) + (v[j].z * v[j].z + v[j].w * v[j].w); }
        const float rs = 1.0f / sqrtf(wave_sum(s) * (1.f / DM) + 1e-6f);
#pragma unroll
        for (int j = 0; j < 4; ++j) { const f32x4 x1 = xo[j]; orow[64 * j] = x1 + v[j] * rs * g3[j]; }
    }
}

constexpr int NPH = 12;
template <int LO, int HI> __global__ void __launch_bounds__(NTHR, 2) mk_fwd(Args a) {
    extern __shared__ __attribute__((aligned(16))) unsigned char lds_raw[];
    LAS unsigned char* lds = (LAS unsigned char*)lds_raw;
    unsigned char* ws = a.ws;
    const int G = gridDim.x, c = blockIdx.x;
    constexpr int lo = LO, hi = HI;
    volatile LAS unsigned* xst = (volatile LAS unsigned*)(lds + 135168 + 64);
    if (threadIdx.x == 0) { xst[0] = 0u; xst[1] = 0u; }
    __syncthreads();
    XcdBarrier bar; bar.bar = (unsigned*)(ws + WS_CTL) + 1024; bar.x = 0; bar.st = nullptr;
    if (hi - lo > 1) bar = xcd_barrier_post((unsigned*)(ws + WS_CTL) + 1024, xst);
    if (a.flags == 0x5eed) cg::this_grid().sync();
#ifdef ONLY_PH
#define IN(k) ((k) == ONLY_PH && lo <= (k) && (k) < hi)
#else
#define IN(k) (lo <= (k) && (k) < hi)
#endif
#define SEAM(k) do { __syncthreads(); if ((k) + 1 < hi) xcd_barrier(bar); } while (0)
    if (IN(0)) { p0_prologue(a, lds); SEAM(0); }
    if (IN(1)) { pg8::Gemm g{(const bf16*)(ws + WS_XN), (const bf16*)(ws + WS_WIN), M, IN_W, DM}; pg8::StaticOrder S; S.init(M, IN_W, G, c);
        EpiG1 E{(bf16*)(ws + WS_ZRW), (bf16*)(ws + WS_ZDA), (bf16*)(ws + WS_ZG)};
        pg8::gemm_phase<EpiG1, pg8::StaticOrder, true, true>(lds, g, S, E); SEAM(1); }
    if (IN(2)) { prep_a(a); SEAM(2); }
    if (IN(3)) { int k3 = 256; asm volatile("" : "+s"(k3)); pg8::Gemm g{(const bf16*)(ws + WS_XN), (const bf16*)(ws + WS_LORA), M, 1536, k3}; pg8::StaticOrder S; S.init(M, 1536, G, c);
        EpiLora E{(bf16*)((unsigned char*)a.out + DO_DEC), (bf16*)((unsigned char*)a.out + DO_A), (bf16*)((unsigned char*)a.out + DO_G), a.in[4], a.in[6]};
        pg8::gemm_phase<EpiLora, pg8::StaticOrder, true, true>(lds, g, S, E); SEAM(3); }
#ifdef SKEL_TEST
    if (IN(4)) { SEAM(4); }
#else
    if (IN(4)) { if (c < SCAN_BLOCKS) { scan_fast(a, lds); __syncthreads(); } attn_queue(a, lds_raw, lds); SEAM(4); }
#endif
    if (IN(5)) { post_rw(a); post_da(a); SEAM(5); }
    if (IN(6)) { pg8::StaticOrder S; S.init(M, DM, G, c);
        { pg8::Gemm g{(const bf16*)((unsigned char*)a.out + DO_RWO), (const bf16*)(ws + WS_WRW), M, DM, 512};
          EpiGate<0> E{(const bf16*)(ws + WS_ZG), 0, (float*)(ws + WS_Y), (bf16*)(ws + WS_MERGED)};
          pg8::gemm_phase<EpiGate<0>, pg8::StaticOrder, true, true>(lds, g, S, E); }
        __syncthreads();
        { pg8::Gemm g{(const bf16*)(ws + WS_DAO), (const bf16*)(ws + WS_WDA), M, DM, 512};
          EpiGate<1> E{(const bf16*)(ws + WS_ZG), DM, (float*)(ws + WS_Y), (bf16*)(ws + WS_MERGED)};
          pg8::gemm_phase<EpiGate<1>, pg8::StaticOrder, true, true>(lds, g, S, E); }
        SEAM(6); }
    if (IN(7)) { pg8::Gemm g{(const bf16*)(ws + WS_MERGED), (const bf16*)(ws + WS_WO), M, DM, DM}; pg8::StaticOrder S; S.init(M, DM, G, c);
        EpiF32 E{(float*)(ws + WS_Y), DM};
        pg8::gemm_phase<EpiF32, pg8::StaticOrder, true, true>(lds, g, S, E); SEAM(7); }
    if (IN(8)) { rows1(a); SEAM(8); }
    if (IN(9)) { pg8::Gemm g{(const bf16*)(ws + WS_XN), (const bf16*)(ws + WS_WUP), M, FF, DM}; pg8::StaticOrder S; S.init(M, FF, G, c);
        EpiRelu2 E{(bf16*)(ws + WS_H), FF};
        pg8::gemm_phase<EpiRelu2, pg8::StaticOrder, true, true>(lds, g, S, E); SEAM(9); }
    if (IN(10)) { pg8::Gemm g{(const bf16*)(ws + WS_H), (const bf16*)(ws + WS_WDN), M, DM, FF}; pg8::StaticOrder S; S.init(M, DM, G, c);
        EpiF32 E{(float*)(ws + WS_F), DM};
        pg8::gemm_phase<EpiF32, pg8::StaticOrder, true, true>(lds, g, S, E); SEAM(10); }
    if (IN(11)) { rows2(a); }
#undef IN
#undef SEAM
}

#ifndef MK_ONE_LAUNCH
#define MK_ONE_LAUNCH 1
#endif
template <int PH> static void launch_phases(const Args& a, int grid, hipStream_t stream) {
    hipLaunchKernelGGL((mk_fwd<PH, PH + 1>), dim3(grid), dim3(NTHR), LDS_BYTES, stream, a);
    if constexpr (PH + 1 < NPH) launch_phases<PH + 1>(a, grid, stream);
}
template <int PH> static bool set_lds_attr() {
    bool ok = hipFuncSetAttribute((const void*)mk_fwd<PH, PH + 1>, hipFuncAttributeMaxDynamicSharedMemorySize, LDS_BYTES) == hipSuccess;
    if constexpr (PH + 1 < NPH) ok = set_lds_attr<PH + 1>() && ok;
    return ok;
}
extern "C" void kernel_launch(void* const* d_in, const int* in_sizes, int n_in, void* d_out, int out_size, void* d_ws, size_t ws_size, hipStream_t stream) {
    static int grid = 0;
    if (grid == 0) {
        if (n_in != 27 || in_sizes[0] != M * DM || out_size != M * DM || ws_size < WS_END) { fprintf(stderr, "kernel_launch: unexpected shapes: n_in %d in0 %d out %d ws %zu\n", n_in, n_in > 0 ? in_sizes[0] : -1, out_size, ws_size); grid = -1; return; }
        int dev = 0, cus = 0;
        (void)hipGetDevice(&dev); (void)hipDeviceGetAttribute(&cus, hipDeviceAttributeMultiprocessorCount, dev);
#if MK_ONE_LAUNCH
        bool ok = hipFuncSetAttribute((const void*)mk_fwd<0, NPH>, hipFuncAttributeMaxDynamicSharedMemorySize, LDS_BYTES) == hipSuccess;
#elif defined(ONLY4)
        bool ok = true;
#else
        bool ok = set_lds_attr<0>();
#endif
        if (!ok) { fprintf(stderr, "kernel_launch: hipFuncSetAttribute failed\n"); grid = -1; return; }
        grid = cus;
    }
    if (grid < 0) return;
    (void)hipMemsetAsync((char*)d_ws + WS_CTL, 0, 32768, stream);
    Args a{};
    for (int i = 0; i < 27; ++i) a.in[i] = (const float*)d_in[i];
    a.out = (float*)d_out; a.ws = (unsigned char*)d_ws;
#if MK_ONE_LAUNCH
    void* args[] = {&a};
    hipError_t e = hipLaunchCooperativeKernel((const void*)mk_fwd<0, NPH>, dim3(grid), dim3(NTHR), args, LDS_BYTES, stream);
    if (e != hipSuccess) fprintf(stderr, "cooperative launch failed: %s (grid %d)\n", hipGetErrorString(e), grid);
#elif defined(ONLY4)
    hipLaunchKernelGGL((mk_fwd<4, 5>), dim3(grid), dim3(NTHR), LDS_BYTES, stream, a);
#else
    launch_phases<0>(a, grid, stream);
#endif
}
```
